# Optimizing an MI355X kernel written in HIP

```python
import math
import jax, jax.numpy as jnp
from jax import lax
import numpy as np

D_MODEL = 1024
BATCH = 2
SEQ = 8192
DEPTH = 2

N_MEM = 256
MEM_HEADS = 4
MEM_HEAD_DIM = 64
MEM_WIDTH = MEM_HEADS * MEM_HEAD_DIM
MIX_WIDTH = D_MODEL - MEM_WIDTH
CONV_WIDTH = 3
DIFF_HEAD_DIM = 64
DIFF_HEADS = MIX_WIDTH // (2 * DIFF_HEAD_DIM)
ROT_DIM = DIFF_HEAD_DIM // 4
ROPE_THETA = 500000.0
D_FF = ((8 * D_MODEL // 3 + 255) // 256) * 256
Q_BLOCK = 128
N_A = DEPTH // 2
N_B = DEPTH - N_A
EPS = 1e-6
MAX_POS_OFFSET = 4096

kernel_name = "yoco_shortconv_diffattn_macaron_memory"


def rmsnorm(x, g):
    xf = x.astype(jnp.float32)
    y = xf * lax.rsqrt(jnp.mean(xf * xf, axis=-1, keepdims=True) + EPS)
    return (y * g.astype(jnp.float32)).astype(x.dtype)


def swiglu(x, w1, w2):
    gate, up = jnp.split(x @ w1, 2, axis=-1)
    return (jax.nn.silu(gate) * up) @ w2


def rope_tables(positions):
    inv_freq = ROPE_THETA ** (-jnp.arange(0, ROT_DIM, 2, dtype=jnp.float32) / ROT_DIM)
    ang = positions.astype(jnp.float32)[..., None] * inv_freq
    return jnp.cos(ang), jnp.sin(ang)


def partial_rope(x, cos, sin):
    bshape = cos.shape[:2] + (1,) * (x.ndim - 3) + cos.shape[-1:]
    c = cos.reshape(bshape)
    s = sin.reshape(bshape)
    xf = x.astype(jnp.float32)
    x1 = xf[..., :ROT_DIM // 2]
    x2 = xf[..., ROT_DIM // 2:ROT_DIM]
    out = jnp.concatenate([x1 * c - x2 * s, x2 * c + x1 * s, xf[..., ROT_DIM:]], axis=-1)
    return out.astype(x.dtype)


def memory_kv(mem, g, w):
    kv = rmsnorm(mem, g) @ w
    k, v = jnp.split(kv, 2, axis=-1)
    shp = mem.shape[:2] + (MEM_HEADS, MEM_HEAD_DIM)
    return k.reshape(shp), v.reshape(shp)


def memory_attention(q, k, v):
    b, s, _ = q.shape
    qh = q.reshape(b, s, MEM_HEADS, MEM_HEAD_DIM)
    sc = jnp.einsum('bshd,bmhd->bhsm', qh, k, preferred_element_type=jnp.float32) * (MEM_HEAD_DIM ** -0.5)
    p = jax.nn.softmax(sc, axis=-1)
    o = jnp.einsum('bhsm,bmhd->bshd', p, v.astype(jnp.float32))
    return o.reshape(b, s, MEM_WIDTH).astype(q.dtype)


def causal_short_conv(x, w):
    return lax.conv_general_dilated(
        x, w[:, None, :].astype(x.dtype), window_strides=(1,),
        padding=[(CONV_WIDTH - 1, 0)], dimension_numbers=('NWC', 'WIO', 'NWC'),
        feature_group_count=x.shape[-1])


def differential_attention(q, k, v, lam):
    b, s = q.shape[:2]
    scale = DIFF_HEAD_DIM ** -0.5
    key_idx = jnp.arange(s)
    vf = v.astype(jnp.float32)

    def q_block(start):
        qb = lax.dynamic_slice_in_dim(q, start, Q_BLOCK, axis=1)
        sc = jnp.einsum('bqhcd,bkhcd->bhcqk', qb, k, preferred_element_type=jnp.float32) * scale
        causal = (start + jnp.arange(Q_BLOCK))[:, None] >= key_idx[None, :]
        p = jax.nn.softmax(jnp.where(causal, sc, -jnp.inf), axis=-1)
        a = p[:, :, 0] - lam * p[:, :, 1]
        return jnp.einsum('bhqk,bkhe->bqhe', a, vf)

    starts = jnp.arange(s // Q_BLOCK) * Q_BLOCK
    out = lax.map(q_block, starts)
    return jnp.moveaxis(out, 0, 1).reshape(b, s, DIFF_HEADS, 2 * DIFF_HEAD_DIM).astype(v.dtype)


def setup_inputs(seed: int = 0) -> dict:
    key = jax.random.key(seed)
    ks = jax.random.split(key, 24)
    f32 = jnp.float32

    def nrm(k, shape, fan_in):
        return jax.random.normal(k, shape, f32) * (fan_in ** -0.5)

    def gain(k, shape):
        return 1.0 + 0.02 * jax.random.normal(k, shape, f32)

    x = jax.random.normal(ks[0], (BATCH, SEQ, D_MODEL), f32)
    mem = jax.random.normal(ks[1], (BATCH, N_MEM, D_MODEL), f32)
    offsets = jax.random.randint(ks[2], (BATCH, 1), 0, MAX_POS_OFFSET, dtype=jnp.int32)
    positions = (offsets + jnp.arange(SEQ, dtype=jnp.int32)[None, :]).astype(jnp.int32)
    return {
        "x": x,
        "mem": mem,
        "positions": positions,
        "ffn_pre_norm": gain(ks[3], (DEPTH, D_MODEL)),
        "ffn_pre_w1": nrm(ks[4], (DEPTH, D_MODEL, 2 * D_FF), D_MODEL),
        "ffn_pre_w2": nrm(ks[5], (DEPTH, D_FF, D_MODEL), D_FF),
        "mix_norm": gain(ks[6], (DEPTH, D_MODEL)),
        "mem_norm": gain(ks[7], (DEPTH, D_MODEL)),
        "mem_w_kv": nrm(ks[8], (DEPTH, D_MODEL, 2 * MEM_WIDTH), D_MODEL),
        "a_w_in": nrm(ks[9], (N_A, D_MODEL, 3 * MIX_WIDTH + MEM_WIDTH), D_MODEL),
        "a_conv_w": nrm(ks[10], (N_A, CONV_WIDTH, MIX_WIDTH), CONV_WIDTH),
        "a_w_out": nrm(ks[11], (N_A, MIX_WIDTH + MEM_WIDTH, D_MODEL), MIX_WIDTH + MEM_WIDTH),
        "kv_norm": gain(ks[12], (D_MODEL,)),
        "kv_w": nrm(ks[13], (D_MODEL, 2 * MIX_WIDTH), D_MODEL),
        "b_w_q": nrm(ks[14], (N_B, D_MODEL, MIX_WIDTH + MEM_WIDTH), D_MODEL),
        "b_lambda": 0.1 * jax.random.normal(ks[15], (N_B, 4, DIFF_HEAD_DIM), f32),
        "b_subln": gain(ks[16], (N_B, 2 * DIFF_HEAD_DIM)),
        "b_w_out": nrm(ks[17], (N_B, MIX_WIDTH + MEM_WIDTH, D_MODEL), MIX_WIDTH + MEM_WIDTH),
        "ffn_post_norm": gain(ks[18], (DEPTH, D_MODEL)),
        "ffn_post_w1": nrm(ks[19], (DEPTH, D_MODEL, 2 * D_FF), D_MODEL),
        "ffn_post_w2": nrm(ks[20], (DEPTH, D_FF, D_MODEL), D_FF),
        "final_norm": gain(ks[21], (D_MODEL,)),
    }


def reference(x, mem, positions, ffn_pre_norm, ffn_pre_w1, ffn_pre_w2, mix_norm, mem_norm,
              mem_w_kv, a_w_in, a_conv_w, a_w_out, kv_norm, kv_w, b_w_q, b_lambda, b_subln,
              b_w_out, ffn_post_norm, ffn_post_w1, ffn_post_w2, final_norm):
    b, s, _ = x.shape
    cos, sin = rope_tables(positions)
    h = x
    k_sh = None
    v_sh = None
    for l in range(DEPTH):
        if l == N_A:
            kv = rmsnorm(h, kv_norm) @ kv_w
            k_sh = partial_rope(kv[..., :MIX_WIDTH].reshape(b, s, DIFF_HEADS, 2, DIFF_HEAD_DIM), cos, sin)
            v_sh = kv[..., MIX_WIDTH:].reshape(b, s, DIFF_HEADS, 2 * DIFF_HEAD_DIM)

        h = h + 0.5 * swiglu(rmsnorm(h, ffn_pre_norm[l]), ffn_pre_w1[l], ffn_pre_w2[l])

        mk, mv = memory_kv(mem, mem_norm[l], mem_w_kv[l])
        u = rmsnorm(h, mix_norm[l])
        if l < N_A:
            proj = u @ a_w_in[l]
            b_gate = proj[..., :MIX_WIDTH]
            c_gate = proj[..., MIX_WIDTH:2 * MIX_WIDTH]
            x_in = proj[..., 2 * MIX_WIDTH:3 * MIX_WIDTH]
            q_mem = proj[..., 3 * MIX_WIDTH:]
            y_main = b_gate * causal_short_conv(c_gate * x_in, a_conv_w[l])
            y_mem = memory_attention(q_mem, mk, mv)
            h = h + jnp.concatenate([y_main, y_mem], axis=-1) @ a_w_out[l]
        else:
            j = l - N_A
            lam_init = 0.8 - 0.6 * math.exp(-0.3 * l)
            proj = u @ b_w_q[j]
            q = partial_rope(proj[..., :MIX_WIDTH].reshape(b, s, DIFF_HEADS, 2, DIFF_HEAD_DIM), cos, sin)
            q_mem = proj[..., MIX_WIDTH:]
            lp = b_lambda[j].astype(jnp.float32)
            lam = jnp.exp(jnp.sum(lp[0] * lp[1])) - jnp.exp(jnp.sum(lp[2] * lp[3])) + lam_init
            o = differential_attention(q, k_sh, v_sh, lam)
            y_main = (rmsnorm(o, b_subln[j]) * (1.0 - lam_init)).reshape(b, s, MIX_WIDTH)
            y_mem = memory_attention(q_mem, mk, mv)
            h = h + jnp.concatenate([y_main, y_mem], axis=-1) @ b_w_out[j]

        h = h + 0.5 * swiglu(rmsnorm(h, ffn_post_norm[l]), ffn_post_w1[l], ffn_post_w2[l])
    return rmsnorm(h, final_norm)
```

```cpp
#include <hip/hip_runtime.h>
#include <cstdio>
#include <cstdint>
namespace pg8 {
#define PG8_LAS __attribute__((address_space(3)))
typedef unsigned short bf16_t;
typedef short bf16x8 __attribute__((ext_vector_type(8)));
typedef float f32x4 __attribute__((ext_vector_type(4)));
typedef unsigned u32x4 __attribute__((ext_vector_type(4)));
constexpr int BM = 256, BK = 64, HALF = 128, HTB = HALF * BK * 2  , STAGE_BYTES = 8 * HTB, NXCD = 8, WGM = 8;

__host__ __device__ __forceinline__ int lds_byte(int r, int c) { const int st = (r >> 4) * 2 + (c >> 5), rr = r & 15, cc = c & 31, ob = rr * 64 + cc * 2; return st * 1024 + (ob ^ (((ob >> 9) & 1) << 5)); }
__host__ __device__ __forceinline__ void stage_rc(int b, int& R, int& C) { const int st = b / 1024, sb = b % 1024, swz = sb ^ (((sb >> 9) & 1) << 5); R = (st >> 1) * 16 + swz / 64; C = (st & 1) * 32 + (swz % 64) / 2; }
__host__ __device__ __forceinline__ int perm32(int rho) { const int n = rho >> 4, i = rho & 15; return 8 * (i >> 2) + 4 * n + (i & 3); }

struct Unit { int pm, pn; };
struct Gemm { const bf16_t* A; const bf16_t* Bt; int M, N, K; };

struct StaticOrder {
    int nM, nN, nwg, G, c;
    __host__ __device__ void init(int M, int N, int G_, int c_) { nM = M / BM; nN = N / BM; nwg = nM * nN; G = G_; c = c_; }
    __host__ __device__ bool next(int i, Unit& u) const {
        const long L = (long)i * G + c; if (L >= nwg) return false;
        int wgid = (int)L; { const int q = nwg / NXCD, r = nwg % NXCD, xcd = wgid % NXCD, off = wgid / NXCD; wgid = (xcd < r ? xcd * (q + 1) : r * (q + 1) + (xcd - r) * q) + off; }
        const int nig = WGM * nN, gid = wgid / nig, fm = gid * WGM, gsz = (nM - fm) < WGM ? (nM - fm) : WGM;
        u.pm = fm + ((wgid % nig) % gsz); u.pn = (wgid % nig) / gsz; return true;
    }
    __device__ __forceinline__ void a_ready(const Unit&) const {}
    __device__ __forceinline__ void done(const Unit&) const {}
};
typedef float f32x2 __attribute__((ext_vector_type(2))); typedef __bf16 bf16x2_t __attribute__((ext_vector_type(2)));
__device__ __forceinline__ unsigned cvt_pk_bf16(float lo, float hi) { const f32x2 v = {lo, hi}; const bf16x2_t b = __builtin_convertvector(v, bf16x2_t); return __builtin_bit_cast(unsigned, b); }
constexpr float RMS_EPS = 1e-6f;
__device__ __forceinline__ void prefetch_stats(float (&pre)[8], const float* ssq, const Unit& u, int wr, int fr, int fq) {
    const float* p = ssq + (size_t)(u.pm * BM + wr * 64 + fr) * 4 + fq;
#pragma unroll
    for (int ai = 0; ai < 2; ++ai)
#pragma unroll
        for (int m = 0; m < 4; ++m) pre[ai * 4 + m] = p[(size_t)(ai * HALF + m * 16) * 4];
}
__device__ __forceinline__ float row_rstd(float part) {
    float s = part; s += __shfl_xor(s, 16); s += __shfl_xor(s, 32);
    return __builtin_amdgcn_rsqf(s * (1.0f / 1024.0f) + RMS_EPS);
}
__device__ __forceinline__ float silu_mul(float g, float u) { return g * u * __builtin_amdgcn_rcpf(1.0f + __builtin_amdgcn_exp2f(-1.4426950408889634f * g)); }
__device__ __forceinline__ void store16_wt(void* p, const u32x4 v) { asm volatile("global_store_dwordx4 %0, %1, off sc1\n\ts_nop 1" :: "v"(p), "v"(v) : "memory"); }
__device__ __forceinline__ u32x4 pack8(const f32x4 v0, const f32x4 v1) { u32x4 w; w.x = cvt_pk_bf16(v0[0], v0[1]); w.y = cvt_pk_bf16(v0[2], v0[3]); w.z = cvt_pk_bf16(v1[0], v1[1]); w.w = cvt_pk_bf16(v1[2], v1[3]); return w; }

struct EpiSwiGLU {
    static constexpr bool PERM = true, AFTER_DRAIN = false;
    bf16_t* O; int ldc; const float* ssq; int npre; bf16_t* O2; int ld2; const float* cs;
    __device__ __forceinline__ void prefetch(float (&pre)[8], const Unit& u, int wr, int fr, int fq) const { prefetch_stats(pre, ssq, u, wr, fr, fq); }
    __device__ __forceinline__ void operator()(const f32x4 (&acc)[2][2][4][2], const Unit& u, int wr, int wc, int fr, int fq, const float (&pre)[8]) const {
        const int row0 = u.pm * BM + wr * 64 + fr;
        if (u.pn < npre) {
            const int col0 = u.pn * BM + wc * 32 + 8 * fq; const bool rot = (u.pn < 3) && ((wc & 1) == 0) && (fq < 2);
#pragma unroll
            for (int ai = 0; ai < 2; ++ai)
#pragma unroll
                for (int m = 0; m < 4; ++m) { const int row = row0 + ai * HALF + m * 16; const float rs = row_rstd(pre[ai * 4 + m]);
                    f32x4 c4 = (f32x4){1.f, 1.f, 1.f, 1.f}, s4 = (f32x4){0.f, 0.f, 0.f, 0.f};
                    if (rot) { c4 = *(const f32x4*)(cs + (size_t)row * 16 + 4 * fq); s4 = *(const f32x4*)(cs + (size_t)row * 16 + 8 + 4 * fq); }
#pragma unroll
                    for (int bj = 0; bj < 2; ++bj) { const f32x4 v0 = acc[ai][bj][m][0] * rs, v1 = acc[ai][bj][m][1] * rs; f32x4 o0, o1;
                        o0[0] = v0[0] * c4[0] - v0[1] * s4[0]; o0[1] = v0[1] * c4[0] + v0[0] * s4[0]; o0[2] = v0[2] * c4[1] - v0[3] * s4[1]; o0[3] = v0[3] * c4[1] + v0[2] * s4[1];
                        o1[0] = v1[0] * c4[2] - v1[1] * s4[2]; o1[1] = v1[1] * c4[2] + v1[0] * s4[2]; o1[2] = v1[2] * c4[3] - v1[3] * s4[3]; o1[3] = v1[3] * c4[3] + v1[2] * s4[3];
                        store16_wt(O2 + (size_t)row * ld2 + col0 + bj * HALF, pack8(o0, o1)); } }
            return;
        }
        const int col0 = (u.pn - npre) * HALF + wc * 32 + 8 * fq;
#pragma unroll
        for (int ai = 0; ai < 2; ++ai)
#pragma unroll
            for (int m = 0; m < 4; ++m) { const int row = row0 + ai * HALF + m * 16; const float rs = row_rstd(pre[ai * 4 + m]), nt = rs * -1.4426950408889634f;
                f32x4 o[2];
#pragma unroll
                for (int n = 0; n < 2; ++n) { const f32x4 g = acc[ai][0][m][n], uu = acc[ai][1][m][n]; const f32x4 t = g * nt; f32x4 e;
                    e[0] = __builtin_amdgcn_exp2f(t[0]); e[1] = __builtin_amdgcn_exp2f(t[1]); e[2] = __builtin_amdgcn_exp2f(t[2]); e[3] = __builtin_amdgcn_exp2f(t[3]);
                    const f32x4 d = e + 1.0f; f32x4 r;
                    r[0] = __builtin_amdgcn_rcpf(d[0]); r[1] = __builtin_amdgcn_rcpf(d[1]); r[2] = __builtin_amdgcn_rcpf(d[2]); r[3] = __builtin_amdgcn_rcpf(d[3]);
                    o[n] = ((g * rs) * r) * (uu * rs); }
                store16_wt(O + (size_t)row * ldc + col0, pack8(o[0], o[1])); }
    }
};
__device__ __forceinline__ float bfl(unsigned w) { return __builtin_bit_cast(float, w << 16); }
__device__ __forceinline__ float bfh(unsigned w) { return __builtin_bit_cast(float, w & 0xffff0000u); }
struct EpiRes {
    static constexpr bool PERM = true, AFTER_DRAIN = false;
    bf16_t* hb; float* ssq; float scale; PG8_LAS float* red;
    __device__ __forceinline__ void prefetch(float (&pre)[8], const Unit&, int, int, int) const {}
    __device__ __forceinline__ void operator()(const f32x4 (&acc)[2][2][4][2], const Unit& u, int wr, int wc, int fr, int fq, const float (&pre)[8]) const {
        const int rl0 = wr * 64 + fr, row0 = u.pm * BM + rl0, col0 = u.pn * BM + wc * 32 + 8 * fq;
#pragma unroll
        for (int ai = 0; ai < 2; ++ai)
#pragma unroll
            for (int m = 0; m < 4; ++m) { const int row = row0 + ai * HALF + m * 16; bf16_t* p = hb + (size_t)row * 1024 + col0; float ss = 0.f;
#pragma unroll
                for (int bj = 0; bj < 2; ++bj) { const u32x4 w = *(const u32x4*)(p + bj * HALF);
                    const f32x4 b0 = (f32x4){bfl(w.x), bfh(w.x), bfl(w.y), bfh(w.y)}, b1 = (f32x4){bfl(w.z), bfh(w.z), bfl(w.w), bfh(w.w)};
                    const f32x4 o0 = b0 + acc[ai][bj][m][0] * scale, o1 = b1 + acc[ai][bj][m][1] * scale;
                    store16_wt(p + bj * HALF, pack8(o0, o1));
                    const f32x4 q = o0 * o0 + o1 * o1; ss += (q[0] + q[1]) + (q[2] + q[3]); }
                ss += __shfl_xor(ss, 16); ss += __shfl_xor(ss, 32);
                if (fq == 0) red[(rl0 + ai * HALF + m * 16) * 4 + wc] = ss; }
        asm volatile("s_waitcnt lgkmcnt(0)" ::: "memory"); __builtin_amdgcn_s_barrier(); asm volatile("" ::: "memory");
        const int tid = (wr * 4 + wc) * 64 + fq * 16 + fr;
        if (tid < BM) { const f32x4 v = *(const PG8_LAS f32x4*)(red + tid * 4); ssq[(size_t)(u.pm * BM + tid) * 4 + u.pn] = (v[0] + v[1]) + (v[2] + v[3]); }
        asm volatile("s_waitcnt lgkmcnt(0)" ::: "memory"); __builtin_amdgcn_s_barrier(); asm volatile("" ::: "memory");
    }
};
struct EpiScale {
    static constexpr bool PERM = true, AFTER_DRAIN = false;
    bf16_t* O; int ldc; const float* ssq;
    __device__ __forceinline__ void prefetch(float (&pre)[8], const Unit& u, int wr, int fr, int fq) const { prefetch_stats(pre, ssq, u, wr, fr, fq); }
    __device__ __forceinline__ void operator()(const f32x4 (&acc)[2][2][4][2], const Unit& u, int wr, int wc, int fr, int fq, const float (&pre)[8]) const {
        const int row0 = u.pm * BM + wr * 64 + fr, col0 = u.pn * BM + wc * 32 + 8 * fq;
#pragma unroll
        for (int ai = 0; ai < 2; ++ai)
#pragma unroll
            for (int m = 0; m < 4; ++m) { const int row = row0 + ai * HALF + m * 16; const float rs = row_rstd(pre[ai * 4 + m]);
#pragma unroll
                for (int bj = 0; bj < 2; ++bj) store16_wt(O + (size_t)row * ldc + col0 + bj * HALF, pack8(acc[ai][bj][m][0] * rs, acc[ai][bj][m][1] * rs)); }
    }
};
struct EpiRope {
    static constexpr bool PERM = true, AFTER_DRAIN = false;
    bf16_t* O; int ldc; const float* ssq; const float* cs; float rscale;
    __device__ __forceinline__ void prefetch(float (&pre)[8], const Unit& u, int wr, int fr, int fq) const { prefetch_stats(pre, ssq, u, wr, fr, fq); }
    __device__ __forceinline__ void operator()(const f32x4 (&acc)[2][2][4][2], const Unit& u, int wr, int wc, int fr, int fq, const float (&pre)[8]) const {
        const int row0 = u.pm * BM + wr * 64 + fr, col0 = u.pn * BM + wc * 32 + 8 * fq;
        const bool ropet = u.pn < 3, rot = ropet && ((wc & 1) == 0) && (fq < 2);
        const float sc = ropet ? rscale : 1.0f;
#pragma unroll
        for (int ai = 0; ai < 2; ++ai)
#pragma unroll
            for (int m = 0; m < 4; ++m) { const int row = row0 + ai * HALF + m * 16; const float rs = row_rstd(pre[ai * 4 + m]) * sc;
                f32x4 c4 = (f32x4){1.f, 1.f, 1.f, 1.f}, s4 = (f32x4){0.f, 0.f, 0.f, 0.f};
                if (rot) { c4 = *(const f32x4*)(cs + (size_t)row * 16 + 4 * fq); s4 = *(const f32x4*)(cs + (size_t)row * 16 + 8 + 4 * fq); }
#pragma unroll
                for (int bj = 0; bj < 2; ++bj) { const f32x4 v0 = acc[ai][bj][m][0] * rs, v1 = acc[ai][bj][m][1] * rs; f32x4 o0, o1;
                    o0[0] = v0[0] * c4[0] - v0[1] * s4[0]; o0[1] = v0[1] * c4[0] + v0[0] * s4[0]; o0[2] = v0[2] * c4[1] - v0[3] * s4[1]; o0[3] = v0[3] * c4[1] + v0[2] * s4[1];
                    o1[0] = v1[0] * c4[2] - v1[1] * s4[2]; o1[1] = v1[1] * c4[2] + v1[0] * s4[2]; o1[2] = v1[2] * c4[3] - v1[3] * s4[3]; o1[3] = v1[3] * c4[3] + v1[2] * s4[3];
                    store16_wt(O + (size_t)row * ldc + col0 + bj * HALF, pack8(o0, o1)); } }
    }
};

template <class Epi, class Sched, bool ALIGN_EPI = false, bool SP2 = false>
__device__ __forceinline__ void gemm_phase(PG8_LAS unsigned char* lds, const Gemm g, const Sched& S, const Epi& E) {
    int tid_ = threadIdx.x; asm volatile("" : "+v"(tid_));
    const int tid = tid_, wid = __builtin_amdgcn_readfirstlane(tid >> 6), lane = tid & 63, wr = wid >> 2, wc = wid & 3, fr = lane & 15, fq = lane >> 4;
    const int K = g.K, nt = K / BK;
    unsigned voffA[2], voffB[2];
#pragma unroll
    for (int i = 0; i < 2; ++i) { int R, C; stage_rc(tid * 16 + i * 8192, R, C); const int Rb = Epi::PERM ? ((R & ~31) + perm32(R & 31)) : R;
        voffA[i] = (unsigned)(R * K + C) * 2u; voffB[i] = (unsigned)(Rb * K + C) * 2u; }
    const size_t kstep = (size_t)(BK * 2);
    const size_t hstep = (size_t)HALF * K * 2;
    const size_t tstep = 2 * hstep;
    const unsigned ldsw = (unsigned)wid * 1024u;
    const int aoff = lds_byte(wr * 64 + fr, fq * 8), boff = lds_byte(wc * 32 + fr, fq * 8);
#define PG8_SA(b, h) (((b) * 2 + (h)) * HTB)
#define PG8_SB(b, h) ((4 + (b) * 2 + (h)) * HTB)
#define PG8_STAGE(bufoff, gbase, voff) do { _Pragma("unroll") for (int _i = 0; _i < 2; ++_i) \
        __builtin_amdgcn_global_load_lds((const unsigned*)((const char*)(gbase) + (voff)[_i]), (PG8_LAS unsigned*)(lds + (bufoff) + ldsw + _i * 8192), 16, 0, 0); } while (0)
#define PG8_LDA(dst, b, h) do { _Pragma("unroll") for (int m = 0; m < 4; ++m) _Pragma("unroll") for (int k = 0; k < 2; ++k) dst[m][k] = *(const PG8_LAS bf16x8*)(lds + PG8_SA(b, h) + aoff + m * 2048 + k * 1024); } while (0)
#define PG8_LDB(dst, b, h) do { _Pragma("unroll") for (int n = 0; n < 2; ++n) _Pragma("unroll") for (int k = 0; k < 2; ++k) dst[n][k] = *(const PG8_LAS bf16x8*)(lds + PG8_SB(b, h) + boff + n * 2048 + k * 1024); } while (0)
#define PG8_MMA(ai, bj, At, Bt) do { __builtin_amdgcn_s_setprio(1); _Pragma("unroll") for (int m = 0; m < 4; ++m) _Pragma("unroll") for (int n = 0; n < 2; ++n) _Pragma("unroll") for (int k = 0; k < 2; ++k) \
        acc[ai][bj][m][n] = __builtin_amdgcn_mfma_f32_16x16x32_bf16(Bt[n][k], At[m][k], acc[ai][bj][m][n], 0, 0, 0); __builtin_amdgcn_s_setprio(0); } while (0)
#define PG8_WAIT_V(n) asm volatile("s_waitcnt vmcnt(" #n ")" ::: "memory")
#define PG8_WAIT_L(n) asm volatile("s_waitcnt lgkmcnt(" #n ")" ::: "memory")
#define PG8_BAR __builtin_amdgcn_s_barrier()
#define PG8_SCHED __builtin_amdgcn_sched_barrier(0)
    Unit cur, nxt; int ui = 0;
    if (!S.next(0, cur)) return;
    f32x4 acc[2][2][4][2];
#pragma unroll
    for (int a = 0; a < 2; ++a)
#pragma unroll
        for (int b = 0; b < 2; ++b)
#pragma unroll
            for (int m = 0; m < 4; ++m)
#pragma unroll
                for (int n = 0; n < 2; ++n) acc[a][b][m][n] = (f32x4){0.f, 0.f, 0.f, 0.f};
    bf16x8 At[4][2], B0[2][2], B1[2][2]; float pre[8] = {0.f, 0.f, 0.f, 0.f, 0.f, 0.f, 0.f, 0.f};
    const char* cA = (const char*)g.A + (size_t)cur.pm * tstep; const char* cB = (const char*)g.Bt + (size_t)cur.pn * tstep;
    S.a_ready(cur);
    E.prefetch(pre, cur, wr, fr, fq);
    if constexpr (SP2) {
        PG8_STAGE(PG8_SB(0, 0), cB, voffB); PG8_STAGE(PG8_SB(0, 1), cB + hstep, voffB); PG8_STAGE(PG8_SA(0, 0), cA, voffA); PG8_STAGE(PG8_SA(0, 1), cA + hstep, voffA);
        if (wr == 1) PG8_BAR;
        PG8_WAIT_V(2); PG8_BAR;
        PG8_STAGE(PG8_SB(1, 0), cB + kstep, voffB); PG8_STAGE(PG8_SA(1, 0), cA + kstep, voffA); PG8_STAGE(PG8_SB(1, 1), cB + hstep + kstep, voffB);
        PG8_WAIT_V(6); PG8_BAR;
    } else {
        PG8_STAGE(PG8_SB(0, 0), cB, voffB); PG8_STAGE(PG8_SA(0, 0), cA, voffA); PG8_STAGE(PG8_SB(0, 1), cB + hstep, voffB); PG8_STAGE(PG8_SA(0, 1), cA + hstep, voffA);
        if (wr == 1) PG8_BAR;
        PG8_WAIT_V(4); PG8_BAR;
        PG8_STAGE(PG8_SB(1, 0), cB + kstep, voffB); PG8_STAGE(PG8_SA(1, 0), cA + kstep, voffA); PG8_STAGE(PG8_SB(1, 1), cB + hstep + kstep, voffB);
        PG8_WAIT_V(6); PG8_BAR;
    }
    for (;;) {
        const bool has_next = S.next(ui + 1, nxt);
        const char* nA = has_next ? (const char*)g.A + (size_t)nxt.pm * tstep : cA; const char* nB = has_next ? (const char*)g.Bt + (size_t)nxt.pn * tstep : cB;
        for (int t = 0; t < nt; t += 2) {
            const bool last = (t == nt - 2);
            const char* a1 = cA + (size_t)(t + 1) * kstep;
            const char* a2 = last ? nA : cA + (size_t)(t + 2) * kstep; const char* b2 = last ? nB : cB + (size_t)(t + 2) * kstep;
            const char* a3 = a2 + kstep; const char* b3 = b2 + kstep;
            if (last && has_next) S.a_ready(nxt);
            if constexpr (SP2) {
            PG8_LDB(B0, 0, 0); PG8_LDB(B1, 0, 1); PG8_SCHED; PG8_LDA(At, 0, 0); PG8_STAGE(PG8_SA(1, 1), a1 + hstep, voffA);
            PG8_WAIT_V(8); PG8_WAIT_L(0); PG8_BAR; PG8_MMA(0, 0, At, B0); PG8_MMA(0, 1, At, B1); PG8_BAR; PG8_SCHED;
            PG8_LDA(At, 0, 1); PG8_STAGE(PG8_SB(0, 0), b2, voffB); PG8_STAGE(PG8_SB(0, 1), b2 + hstep, voffB); PG8_STAGE(PG8_SA(0, 0), a2, voffA);
            PG8_WAIT_V(8); PG8_WAIT_L(0); PG8_BAR; PG8_MMA(1, 0, At, B0); PG8_MMA(1, 1, At, B1); PG8_BAR; PG8_SCHED;
            PG8_LDB(B0, 1, 0); PG8_LDB(B1, 1, 1); PG8_SCHED; PG8_LDA(At, 1, 0); PG8_STAGE(PG8_SA(0, 1), a2 + hstep, voffA);
            PG8_WAIT_V(8); PG8_WAIT_L(0); PG8_BAR; PG8_MMA(0, 0, At, B0); PG8_MMA(0, 1, At, B1); PG8_BAR; PG8_SCHED;
            PG8_LDA(At, 1, 1); PG8_STAGE(PG8_SB(1, 0), b3, voffB); PG8_STAGE(PG8_SB(1, 1), b3 + hstep, voffB); PG8_STAGE(PG8_SA(1, 0), a3, voffA);
            PG8_WAIT_V(8); PG8_WAIT_L(0); PG8_BAR; PG8_MMA(1, 0, At, B0); PG8_MMA(1, 1, At, B1); PG8_BAR; PG8_SCHED;
            } else {
            PG8_LDB(B0, 0, 0); PG8_SCHED; PG8_LDA(At, 0, 0); PG8_STAGE(PG8_SA(1, 1), a1 + hstep, voffA);
            PG8_WAIT_L(8); PG8_BAR; PG8_WAIT_L(0); PG8_MMA(0, 0, At, B0); PG8_BAR; PG8_SCHED;
            PG8_LDB(B1, 0, 1); PG8_STAGE(PG8_SB(0, 0), b2, voffB);
            PG8_BAR; PG8_WAIT_L(0); PG8_MMA(0, 1, At, B1); PG8_BAR;
            PG8_LDA(At, 0, 1); PG8_STAGE(PG8_SA(0, 0), a2, voffA);
            PG8_BAR; PG8_WAIT_L(0); PG8_MMA(1, 0, At, B0); PG8_BAR; PG8_SCHED;
            PG8_STAGE(PG8_SB(0, 1), b2 + hstep, voffB);
            PG8_WAIT_V(6); PG8_BAR; PG8_MMA(1, 1, At, B1); PG8_BAR;
            PG8_LDB(B0, 1, 0); PG8_SCHED; PG8_LDA(At, 1, 0); PG8_STAGE(PG8_SA(0, 1), a2 + hstep, voffA);
            PG8_WAIT_L(8); PG8_BAR; PG8_WAIT_L(0); PG8_MMA(0, 0, At, B0); PG8_BAR; PG8_SCHED;
            PG8_LDB(B1, 1, 1); PG8_STAGE(PG8_SB(1, 0), b3, voffB);
            PG8_BAR; PG8_WAIT_L(0); PG8_MMA(0, 1, At, B1); PG8_BAR;
            PG8_LDA(At, 1, 1); PG8_STAGE(PG8_SA(1, 0), a3, voffA);
            PG8_BAR; PG8_WAIT_L(0); PG8_MMA(1, 0, At, B0); PG8_BAR; PG8_SCHED;
            PG8_STAGE(PG8_SB(1, 1), b3 + hstep, voffB);
            PG8_WAIT_V(6); PG8_BAR; PG8_MMA(1, 1, At, B1); PG8_BAR;
            }
        }
        if constexpr (ALIGN_EPI) { if (wr == 0) PG8_BAR; }
        if constexpr (!Epi::AFTER_DRAIN) { E(acc, cur, wr, wc, fr, fq, pre); S.done(cur); if (has_next) E.prefetch(pre, nxt, wr, fr, fq); }
        if (!has_next) break;
#pragma unroll
        for (int a = 0; a < 2; ++a)
#pragma unroll
            for (int b = 0; b < 2; ++b)
#pragma unroll
                for (int m = 0; m < 4; ++m)
#pragma unroll
                    for (int n = 0; n < 2; ++n) acc[a][b][m][n] = (f32x4){0.f, 0.f, 0.f, 0.f};
        cur = nxt; cA = nA; cB = nB; ++ui;
        if constexpr (ALIGN_EPI) { if (wr == 1) PG8_BAR; }
    }
    PG8_WAIT_V(0);
    if constexpr (!ALIGN_EPI) { if (wr == 0) PG8_BAR; }
    PG8_BAR;
    if constexpr (Epi::AFTER_DRAIN) { E.fused(acc, cur, wr, wc, fr, fq, lds, wid, lane); S.done(cur); }
#undef PG8_SA
#undef PG8_SB
#undef PG8_STAGE
#undef PG8_LDA
#undef PG8_LDB
#undef PG8_MMA
#undef PG8_WAIT_V
#undef PG8_WAIT_L
#undef PG8_BAR
#undef PG8_SCHED
}
}
#include <hip/hip_bf16.h>
#include <cmath>
namespace attn_body {
using bf16=__hip_bfloat16;
using bf16x8=__attribute__((ext_vector_type(8)))short;
using s16x4=__attribute__((ext_vector_type(4)))short;
using f32x16=__attribute__((ext_vector_type(16)))float;
using u32x4=__attribute__((ext_vector_type(4)))unsigned;
constexpr int BATCH=2,SEQ=8192,D=64;
constexpr int PQ=1024,PK=1536,PV=1536,PO=768;
constexpr int NW=8,QBLK=32,QB=QBLK*NW,KVBLK=64,NQB=SEQ/QB;
constexpr int ATTN_UNIT_ROWS=QB;
__device__ __forceinline__ int crow(int r,int hi){return (r&3)+8*(r>>2)+4*hi;}
#define SBAR() __builtin_amdgcn_sched_barrier(0)
__device__ __forceinline__ void cmask(f32x16&p0,f32x16&p1,int jb,int qrel,int hi){
  const float NEG=-INFINITY; int kb=64*jb+4*hi;
  #pragma unroll
  for(int r=0;r<16;++r){int kv=kb+(r&3)+8*(r>>2); if(kv>qrel)p0[r]=NEG; if(kv+32>qrel)p1[r]=NEG;}
}

constexpr int NSLOT=3, SLOTB=8192;
constexpr int LDS_K=0, LDS_V=NSLOT*SLOTB, LDS_WS=LDS_V+NSLOT*2*SLOTB, LDS_OST=LDS_WS+NW*64*4, LDS_BYTES=LDS_OST+NW*8192;
constexpr float C2=0.125f*1.4426950408889634f;
__device__ __forceinline__ void glds16(const void*gsrc,unsigned lds_dst){unsigned keep;
  asm volatile("s_mov_b32 %0, m0\n\ts_mov_b32 m0, %2\n\ts_nop 0\n\tglobal_load_lds_dwordx4 %1, off\n\ts_mov_b32 m0, %0":"=&s"(keep):"v"(gsrc),"s"(lds_dst):"memory");}
__device__ __forceinline__ float max3f(float a,float b,float c){float r;asm("v_max3_f32 %0, %1, %2, %3":"=v"(r):"v"(a),"v"(b),"v"(c));return r;}
__device__ __forceinline__ float max2f(float a,float b){float r;asm("v_max_f32_e32 %0, %1, %2":"=v"(r):"v"(a),"v"(b));return r;}
__device__ __forceinline__ float fadd_s(float a,float b){float r;asm("v_add_f32_e32 %0, %1, %2":"=v"(r):"v"(a),"v"(b));return r;}
__device__ __forceinline__ float fsub_s(float a,float b){float r;asm("v_sub_f32_e32 %0, %1, %2":"=v"(r):"v"(a),"v"(b));return r;}
typedef float f32x2_t __attribute__((ext_vector_type(2))); typedef __bf16 bf16x2_t __attribute__((ext_vector_type(2)));
__device__ __forceinline__ unsigned cvtpk_s(float lo,float hi){f32x2_t v={lo,hi};bf16x2_t b=__builtin_convertvector(v,bf16x2_t);return __builtin_bit_cast(unsigned,b);}
#define WAIT_BAR(N) asm volatile("s_waitcnt vmcnt(" #N ") lgkmcnt(0)\n\ts_barrier":::"memory")

__device__ __forceinline__ void qkt(f32x16&p0,f32x16&p1,const char*Kslot,const bf16x8*qr,int r32,int hi){
  const char*kb=Kslot+hi*1024+r32*16; const f32x16 z=f32x16{};
  #pragma unroll
  for(int d0=0;d0<4;++d0){
    const bf16x8 b0=*reinterpret_cast<const bf16x8*>(kb+d0*2048);
    const bf16x8 b1=*reinterpret_cast<const bf16x8*>(kb+d0*2048+512);
    if(d0==0){p0=__builtin_amdgcn_mfma_f32_32x32x16_bf16(b0,qr[0],z,0,0,0);p1=__builtin_amdgcn_mfma_f32_32x32x16_bf16(b1,qr[0],z,0,0,0);}
    else{p0=__builtin_amdgcn_mfma_f32_32x32x16_bf16(b0,qr[d0],p0,0,0,0);p1=__builtin_amdgcn_mfma_f32_32x32x16_bf16(b1,qr[d0],p1,0,0,0);}}
}
typedef __attribute__((address_space(3))) const char* lds_cptr;
typedef short v4i16_t __attribute__((ext_vector_type(4)));
__device__ __forceinline__ void kload8(bf16x8*kf,lds_cptr kp){
  kf[0]=*(const __attribute__((address_space(3))) bf16x8*)(kp);      kf[1]=*(const __attribute__((address_space(3))) bf16x8*)(kp+512);
  kf[2]=*(const __attribute__((address_space(3))) bf16x8*)(kp+2048); kf[3]=*(const __attribute__((address_space(3))) bf16x8*)(kp+2560);
  kf[4]=*(const __attribute__((address_space(3))) bf16x8*)(kp+4096); kf[5]=*(const __attribute__((address_space(3))) bf16x8*)(kp+4608);
  kf[6]=*(const __attribute__((address_space(3))) bf16x8*)(kp+6144); kf[7]=*(const __attribute__((address_space(3))) bf16x8*)(kp+6656);
}
__device__ __forceinline__ void kload2(bf16x8*kf,lds_cptr kp,int j){ kf[2*j]=*(const __attribute__((address_space(3))) bf16x8*)(kp+j*2048); kf[2*j+1]=*(const __attribute__((address_space(3))) bf16x8*)(kp+j*2048+512); }
__device__ __forceinline__ s16x4 vtr(lds_cptr p){ return __builtin_bit_cast(s16x4,__builtin_amdgcn_ds_read_tr16_b64_v4i16((__attribute__((address_space(3))) v4i16_t*)p)); }
__device__ __forceinline__ float rowmax(const f32x16&p0,const f32x16&p1){
  float a=max3f(p0[0],p0[1],p1[0]),b=max3f(p0[2],p0[3],p1[1]);a=max3f(a,p1[2],p1[3]);
  #pragma unroll
  for(int r=4;r<16;r+=4){a=max3f(a,p0[r],p0[r+1]);b=max3f(b,p0[r+2],p0[r+3]);a=max3f(a,p1[r],p1[r+1]);b=max3f(b,p1[r+2],p1[r+3]);}
  const float m=max2f(a,b);
  auto rr=__builtin_amdgcn_permlane32_swap(__float_as_uint(m),__float_as_uint(m),false,false);
  return max2f(__uint_as_float(rr[0]),__uint_as_float(rr[1]));
}
__device__ __forceinline__ void pv(f32x16*o,int vb,bf16x8 pa0,bf16x8 pa1,bf16x8 pa2,bf16x8 pa3){
  #pragma unroll
  for(int d0=0;d0<4;++d0){s16x4 lo[4],hi[4];
    #pragma unroll
    for(int ks=0;ks<4;++ks){
      asm volatile("ds_read_b64_tr_b16 %0,%1 offset:%c2":"=&v"(lo[ks]):"v"(vb),"i"(d0*4096+ks*1024):"memory");
      asm volatile("ds_read_b64_tr_b16 %0,%1 offset:%c2":"=&v"(hi[ks]):"v"(vb),"i"(d0*4096+ks*1024+512):"memory");}
    asm volatile("s_waitcnt lgkmcnt(0)":::"memory");SBAR();
    #define PK(k) (bf16x8){lo[k][0],lo[k][1],lo[k][2],lo[k][3],hi[k][0],hi[k][1],hi[k][2],hi[k][3]}
    o[d0]=__builtin_amdgcn_mfma_f32_32x32x16_bf16(pa0,PK(0),o[d0],0,0,0);
    o[d0]=__builtin_amdgcn_mfma_f32_32x32x16_bf16(pa1,PK(1),o[d0],0,0,0);
    o[d0]=__builtin_amdgcn_mfma_f32_32x32x16_bf16(pa2,PK(2),o[d0],0,0,0);
    o[d0]=__builtin_amdgcn_mfma_f32_32x32x16_bf16(pa3,PK(3),o[d0],0,0,0);
    #undef PK
  }
}

#ifndef ATTN_STORE16
#define ATTN_STORE16(p,v) asm volatile("global_store_dwordx4 %0, %1, off sc1\n\ts_nop 1"::"v"(p),"v"(v):"memory")
#endif
template<int THRL,bool FAST> __device__ __forceinline__ bool attn_unit(int qb,const bf16*Qb,const bf16*__restrict__ Kb,const bf16*__restrict__ Vb,bf16*Ob,char*shm){
  int tid_=threadIdx.x; asm volatile("":"+v"(tid_)); const int tid=tid_,lane=tid&63,r32=lane&31,hi=lane>>5; const int wid=__builtin_amdgcn_readfirstlane(tid>>6);
  const int q0=qb*QB;
  const bf16*Qw=Qb+(long)(q0+wid*QBLK)*PQ;
  const bf16*Kh=Kb,*Vh=Vb;
  const unsigned lds0=(unsigned)(uintptr_t)shm;
  float*wsf=(float*)(shm+LDS_WS)+wid*64;
  const bf16*ksrc=Kh+(long)lane*PK+wid*8;
  const bf16*vsrc=Vh+(long)(16*(wid&3)+(lane>>2))*PV+(wid>>2)*32+(lane&3)*8;
  const unsigned kdst=lds0+LDS_K+wid*1024, vdst=lds0+LDS_V+wid*1024;
  #define DMA_K(t,slot) glds16(ksrc+(long)(t)*KVBLK*PK,(unsigned)__builtin_amdgcn_readfirstlane(kdst+(slot)))
  #define DMA_V(t,slot) do{ glds16(vsrc+(long)(t)*KVBLK*PV,(unsigned)__builtin_amdgcn_readfirstlane(vdst+2*(slot))); glds16(vsrc+64+(long)(t)*KVBLK*PV,(unsigned)__builtin_amdgcn_readfirstlane(vdst+2*(slot)+8192)); }while(0)
  const int vb0=(int)(lds0+LDS_V)+((lane>>4)&1)*32+(lane&3)*8+(4*hi+((lane&15)>>2))*64;
  const char*Kbase=shm+LDS_K; bf16x8 kf[8];
  const lds_cptr shm3=(lds_cptr)shm; const lds_cptr kp0=shm3+LDS_K+hi*1024+r32*16; const lds_cptr vp0=shm3+LDS_V+((lane>>4)&1)*32+(lane&3)*8+(4*hi+((lane&15)>>2))*64;
  const int NT=(q0+QB)/KVBLK;
  DMA_K(0,0);DMA_V(0,0);DMA_K(1,SLOTB);
  bf16x8 qr[4];
  #pragma unroll
  for(int d0=0;d0<4;++d0)qr[d0]=*reinterpret_cast<const bf16x8*>(&Qw[(long)r32*PQ+d0*16+hi*8]);
  float mhat=0.f,l_reg=0.f;f32x16 o[4];o[0]=f32x16{};o[1]=f32x16{};o[2]=f32x16{};o[3]=f32x16{};
  const int qrel=wid*QBLK+r32;
  #define CMASK(P0,P1,t) do{int jb_=(t)-(NT-4); if(jb_>=0)cmask(P0,P1,jb_,qrel,hi);}while(0)
  bool resc=false;
  #define START(P0,P1) do{ if constexpr(FAST){ _Pragma("unroll") for(int r=0;r<16;++r){P0[r]=__builtin_amdgcn_exp2f(P0[r]);P1[r]=__builtin_amdgcn_exp2f(P1[r]);} } else { const float rm=rowmax(P0,P1); resc=false; mhat=rm; \
    _Pragma("unroll") for(int r=0;r<16;++r){P0[r]=__builtin_amdgcn_exp2f(fsub_s(P0[r],rm));P1[r]=__builtin_amdgcn_exp2f(fsub_s(P1[r],rm));} } }while(0)
  #define RESC() do{ if(!FAST && resc){ asm volatile("s_waitcnt lgkmcnt(0)":::"memory"); \
      _Pragma("unroll") for(int d_=0;d_<4;++d_) _Pragma("unroll") for(int r=0;r<16;++r)o[d_][r]*=wsf[crow(r,hi)]; } }while(0)
  f32x16 pA0,pA1,pB0,pB1;
  int sl_prev=0,sl_cur=0,sl_next=SLOTB;
  #define ROT() do{sl_prev=sl_cur;sl_cur=sl_next;sl_next=(sl_next==(NSLOT-1)*SLOTB)?0:sl_next+SLOTB;}while(0)
  DMA_K(2,2*SLOTB);
  WAIT_BAR(4);
  qkt(pA0,pA1,Kbase,qr,r32,hi);asm volatile("s_nop 15\n\ts_nop 7":"+v"(pA0),"+v"(pA1));CMASK(pA0,pA1,0);
  START(pA0,pA1);
  WAIT_BAR(0);
  DMA_K(3,0);DMA_V(1,SLOTB);
  ROT();
  kload8(kf,kp0+sl_cur);
  WAIT_BAR(3);
  s16x4 vlo[4],vhi[4]; u32x4 pw0,pw1,pw2,pw3;
  #define PKW(P,B) cvtpk_s(P[B],P[B+1])
  #define PAF(k) __builtin_bit_cast(bf16x8,pw##k)
  #define VFR(i) (bf16x8){vlo[i][0],vlo[i][1],vlo[i][2],vlo[i][3],vhi[i][0],vhi[i][1],vhi[i][2],vhi[i][3]}
  #define PIN(x) asm volatile("":"+v"(x))
  #define MX3(a,b,c) __builtin_fmaxf(__builtin_fmaxf((a),(b)),(c))
  #define GAPA(MF,A0,A1,A2,A3,W0,W1,PW) do{ MF; sacc+=A0; sacc+=A1; sacc+=A2; sacc+=A3; PIN(sacc); W0; W1; PIN(PW); SBAR(); }while(0)
  #define EX(v) __builtin_amdgcn_exp2f(v)
  #define VOFF(m) (((((m)&1)+2*((m)>>3))*4096)+((((m)>>1)&3)*1024))
  #define VRD(m) do{ vlo[(m)&3]=vtr(vp_+VOFF(m)); vhi[(m)&3]=vtr(vp_+VOFF(m)+512); }while(0)
  #define GAPB(MF,RD,X,B) do{ MF; RD; if constexpr(FAST){ X[B]=EX(X[B]); X[B+1]=EX(X[B+1]); } else { X[B]=EX(X[B]-mhat); X[B+1]=EX(X[B+1]-mhat); } PIN(X); SBAR(); }while(0)
  #define NORD do{}while(0)
  #define KRD(G,j) do{ if(G){ kload2(kf,kp0+sl_next,j); SBAR(); } }while(0)
  #define PVM(db,k,f) o[db]=__builtin_amdgcn_mfma_f32_32x32x16_bf16(PAF(k),VFR(f),o[db],0,0,0)
  #define STEP(C0,C1,P0,P1,t,GK,GV,GL) do{ SBAR(); \
    const lds_cptr vp_=vp0+2*sl_prev; const f32x16 z_=f32x16{}; \
    float sacc=(P0[0]+P0[1]); \
    GAPA(C0=__builtin_amdgcn_mfma_f32_32x32x16_bf16(kf[0],qr[0],z_,0,0,0), P0[2],P0[3],P0[4],P0[5],     pw0[0]=PKW(P0,0), pw0[1]=PKW(P0,2), pw0); \
    GAPA(C1=__builtin_amdgcn_mfma_f32_32x32x16_bf16(kf[1],qr[0],z_,0,0,0), P0[6],P0[7],P0[8],P0[9],     pw0[2]=PKW(P0,4), pw0[3]=PKW(P0,6), pw0); \
    GAPA(C0=__builtin_amdgcn_mfma_f32_32x32x16_bf16(kf[2],qr[1],C0,0,0,0),   P0[10],P0[11],P0[12],P0[13], pw1[0]=PKW(P0,8), pw1[1]=PKW(P0,10), pw1); \
    GAPA(C1=__builtin_amdgcn_mfma_f32_32x32x16_bf16(kf[3],qr[1],C1,0,0,0),   P0[14],P0[15],P1[0],P1[1],   pw1[2]=PKW(P0,12),pw1[3]=PKW(P0,14), pw1); \
    VRD(0); SBAR(); GAPA(C0=__builtin_amdgcn_mfma_f32_32x32x16_bf16(kf[4],qr[2],C0,0,0,0),   P1[2],P1[3],P1[4],P1[5],     pw2[0]=PKW(P1,0), pw2[1]=PKW(P1,2), pw2); \
    VRD(1); SBAR(); GAPA(C1=__builtin_amdgcn_mfma_f32_32x32x16_bf16(kf[5],qr[2],C1,0,0,0),   P1[6],P1[7],P1[8],P1[9],     pw2[2]=PKW(P1,4), pw2[3]=PKW(P1,6), pw2); \
    VRD(2); SBAR(); GAPA(C0=__builtin_amdgcn_mfma_f32_32x32x16_bf16(kf[6],qr[3],C0,0,0,0),   P1[10],P1[11],P1[12],P1[13], pw3[0]=PKW(P1,8), pw3[1]=PKW(P1,10), pw3); \
    VRD(3); SBAR(); GAPA(C1=__builtin_amdgcn_mfma_f32_32x32x16_bf16(kf[7],qr[3],C1,0,0,0),   P1[14],P1[15],0.f,0.f,       pw3[2]=PKW(P1,12),pw3[3]=PKW(P1,14), pw3); \
    l_reg+=sacc; \
    if(GK){DMA_K((t)+3,sl_cur);} if(GV){DMA_V((t)+1,sl_next);} \
    CMASK(C0,C1,t); \
        if constexpr(!FAST) { float a=MX3(C0[0],C0[1],C1[0]),b=MX3(C0[2],C0[3],C1[1]); a=MX3(a,C1[2],C1[3]); \
      _Pragma("unroll") for(int r=4;r<16;r+=4){a=MX3(a,C0[r],C0[r+1]);b=MX3(b,C0[r+2],C0[r+3]);a=MX3(a,C1[r],C1[r+1]);b=MX3(b,C1[r+2],C1[r+3]);} \
      float rm=__builtin_fmaxf(a,b); { auto rr=__builtin_amdgcn_permlane32_swap(__float_as_uint(rm),__float_as_uint(rm),false,false); rm=__builtin_fmaxf(__uint_as_float(rr[0]),__uint_as_float(rr[1])); } \
      resc=false; rm-=mhat; \
      if(__builtin_expect(__any(rm>(float)THRL),0)){ const float dl=__builtin_fmaxf(rm,0.f); mhat+=dl; \
        const float f=__builtin_amdgcn_exp2f(-dl); l_reg*=f; if(hi==0)wsf[r32]=f; resc=true; } } \
    SBAR(); \
    GAPB(PVM(0,0,0), VRD(4), C0,0); \
    GAPB(PVM(1,0,1), VRD(5), C0,2); \
    GAPB(PVM(0,1,2), VRD(6), C0,4); \
    GAPB(PVM(1,1,3), VRD(7), C0,6); \
    KRD(GL,0); GAPB(PVM(0,2,0), VRD(8), C0,8); \
    GAPB(PVM(1,2,1), VRD(9), C0,10); \
    KRD(GL,1); GAPB(PVM(0,3,2), VRD(10), C0,12); \
    GAPB(PVM(1,3,3), VRD(11), C0,14); \
    KRD(GL,2); GAPB(PVM(2,0,0), VRD(12), C1,0); \
    GAPB(PVM(3,0,1), VRD(13), C1,2); \
    KRD(GL,3); GAPB(PVM(2,1,2), VRD(14), C1,4); \
    GAPB(PVM(3,1,3), VRD(15), C1,6); \
    GAPB(PVM(2,2,0), NORD, C1,8); \
    GAPB(PVM(3,2,1), NORD, C1,10); \
    GAPB(PVM(2,3,2), NORD, C1,12); \
    GAPB(PVM(3,3,3), NORD, C1,14); \
    }while(0)
  int t=1;
  #undef CMASK
  #define CMASK(P0,P1,t) do{}while(0)
  for(;t+5<NT;t+=2){
    STEP(pB0,pB1,pA0,pA1,t,true,true,true);     WAIT_BAR(3); RESC(); ROT();
    STEP(pA0,pA1,pB0,pB1,t+1,true,true,true);   WAIT_BAR(3); RESC(); ROT();
  }
  #undef CMASK
  #define CMASK(P0,P1,t) do{int jb_=(t)-(NT-4); if(jb_>=0)cmask(P0,P1,jb_,qrel,hi);}while(0)
  #define ENDW(tt) do{ if((tt)+3<NT){WAIT_BAR(3);} else if((tt)+2<NT){WAIT_BAR(2);} else {WAIT_BAR(0);} }while(0)
  for(;t+1<NT;t+=2){
    STEP(pB0,pB1,pA0,pA1,t,(t+3<NT),(t+1<NT),(t+1<NT));       ENDW(t);   RESC(); ROT();
    STEP(pA0,pA1,pB0,pB1,t+1,(t+4<NT),(t+2<NT),(t+2<NT));     ENDW(t+1); RESC(); ROT();
  }
  STEP(pB0,pB1,pA0,pA1,NT-1,false,false,false); RESC();
  { float sacc=pB0[0]+pB0[1]; _Pragma("unroll") for(int r=2;r<16;++r)sacc+=pB0[r]; _Pragma("unroll") for(int r=0;r<16;++r)sacc+=pB1[r]; l_reg+=sacc;
    pw0=(u32x4){PKW(pB0,0),PKW(pB0,2),PKW(pB0,4),PKW(pB0,6)};pw1=(u32x4){PKW(pB0,8),PKW(pB0,10),PKW(pB0,12),PKW(pB0,14)};pw2=(u32x4){PKW(pB1,0),PKW(pB1,2),PKW(pB1,4),PKW(pB1,6)};pw3=(u32x4){PKW(pB1,8),PKW(pB1,10),PKW(pB1,12),PKW(pB1,14)};
    SBAR(); pv(o,vb0+2*sl_cur,PAF(0),PAF(1),PAF(2),PAF(3)); }
  #undef PKW
  #undef PAF
  #undef VFR
  #undef PIN
  #undef MX3
  #undef GAPA
  #undef GAPB
  #undef NORD
  #undef PVM
  #undef VOFF
  #undef EX
  #undef VRD
  #undef KRD
  #undef STEP
  #undef ENDW
  {auto rr=__builtin_amdgcn_permlane32_swap(__float_as_uint(l_reg),__float_as_uint(l_reg),false,false);l_reg=__uint_as_float(rr[0])+__uint_as_float(rr[1]);}
  if(hi==0)wsf[32+r32]=l_reg;asm volatile("s_waitcnt lgkmcnt(0)":::"memory");
  float rli[16];
  #pragma unroll
  for(int r=0;r<16;++r)rli[r]=__builtin_amdgcn_rcpf(wsf[32+crow(r,hi)]);
  bf16*Ow=Ob+(long)(q0+wid*QBLK)*PO;
  { bf16*stg=(bf16*)(shm+LDS_OST)+wid*4096;
    #pragma unroll
    for(int r=0;r<16;++r){const int orow=crow(r,hi);
      #pragma unroll
      for(int d0=0;d0<4;++d0)stg[orow*128+d0*32+r32]=__float2bfloat16(o[d0][r]*rli[r]);}
    asm volatile("s_waitcnt lgkmcnt(0)":::"memory");
    #pragma unroll
    for(int i=0;i<8;++i){const int row=i*4+(lane>>4),ch=lane&15; const u32x4 v=*(const u32x4*)(stg+row*128+ch*8); ATTN_STORE16(Ow+(long)row*PO+ch*8,v);} }
  bool bad=false;
  if constexpr(FAST){ int* flg=(int*)(shm+LDS_WS); asm volatile("s_waitcnt lgkmcnt(0)\n\ts_barrier":::"memory");
    if(tid==0)flg[0]=0; asm volatile("s_waitcnt lgkmcnt(0)\n\ts_barrier":::"memory");
    if(__any(!(l_reg>0x1p-60f&&l_reg<0x1p60f))&&lane==0)flg[0]=1; asm volatile("s_waitcnt lgkmcnt(0)\n\ts_barrier":::"memory");
    bad=flg[0]!=0; }
  asm volatile("s_waitcnt lgkmcnt(0)\n\ts_barrier":::"memory");
  #undef DMA_K
  #undef DMA_V
  #undef CMASK
  #undef START
  #undef RESC
  #undef ROT
  return bad;
}
template<bool LATE> __device__ __forceinline__ bool attn_unit_fast(int qb,const bf16*Qb,const bf16*__restrict__ Kb,const bf16*__restrict__ Vb,bf16*Ob,char*shm){
  int tid_=threadIdx.x; asm volatile("":"+v"(tid_)); const int tid=tid_,lane=tid&63,r32=lane&31,hi=lane>>5; const int wid=__builtin_amdgcn_readfirstlane(tid>>6);
  constexpr int FK=0, FV=4*SLOTB, FWS=FV+4*2*SLOTB, FOST=0;
  const int q0=qb*QB;
  const bf16*Qw=Qb+(long)(q0+wid*QBLK)*PQ;
  const unsigned lds0=(unsigned)(uintptr_t)shm;
  float*wsf=(float*)(shm+FWS)+wid*64;
  const bf16*ksrc=Kb+(long)lane*PK+wid*8;
  const bf16*vsrc=Vb+(long)(16*(wid&3)+(lane>>2))*PV+(wid>>2)*32+(lane&3)*8;
  const unsigned kdst=lds0+FK+wid*1024, vdst=lds0+FV+wid*1024;
  #define KSL(t) (((t)&3)*SLOTB)
  #define RFL(x) ((unsigned)__builtin_amdgcn_readfirstlane(x))
  #define DMA_K(t) glds16(ksrc+(long)(t)*KVBLK*PK,RFL(kdst+KSL(t)))
  #define DMA_V(t) do{ glds16(vsrc+(long)(t)*KVBLK*PV,RFL(vdst+2*KSL(t))); glds16(vsrc+64+(long)(t)*KVBLK*PV,RFL(vdst+2*KSL(t)+8192)); }while(0)
  const int vb0=(int)(lds0+FV)+((lane>>4)&1)*32+(lane&3)*8+(4*hi+((lane&15)>>2))*64;
  bf16x8 kf[8];
  const lds_cptr shm3=(lds_cptr)shm; const lds_cptr kp0=shm3+FK+hi*1024+r32*16; const lds_cptr vp0=shm3+FV+((lane>>4)&1)*32+(lane&3)*8+(4*hi+((lane&15)>>2))*64;
  const int NT=(q0+QB)/KVBLK;
  DMA_K(0);DMA_V(0);DMA_K(1);
  bf16x8 qr[4];
  #pragma unroll
  for(int d0=0;d0<4;++d0)qr[d0]=*reinterpret_cast<const bf16x8*>(&Qw[(long)r32*PQ+d0*16+hi*8]);
  float l_reg=0.f;f32x16 o[4];o[0]=f32x16{};o[1]=f32x16{};o[2]=f32x16{};o[3]=f32x16{};
  const int qrel=wid*QBLK+r32;
  #define CMASK(P0,P1,t) do{int jb_=(t)-(NT-4); if(jb_>=0)cmask(P0,P1,jb_,qrel,hi);}while(0)
  f32x16 pA0,pA1,pB0,pB1;
  DMA_K(2);
  WAIT_BAR(4);
  qkt(pA0,pA1,shm+FK,qr,r32,hi);asm volatile("s_nop 15\n\ts_nop 7":"+v"(pA0),"+v"(pA1));CMASK(pA0,pA1,0);
  _Pragma("unroll") for(int r=0;r<16;++r){pA0[r]=__builtin_amdgcn_exp2f(pA0[r]);pA1[r]=__builtin_amdgcn_exp2f(pA1[r]);}
  WAIT_BAR(0);
  DMA_K(3);DMA_V(1);
  kload8(kf,kp0+KSL(1));
  WAIT_BAR(3);
  s16x4 vlo[4],vhi[4]; u32x4 pw0,pw1,pw2,pw3;
  #define PKW(P,B) cvtpk_s(P[B],P[B+1])
  #define PAF(k) __builtin_bit_cast(bf16x8,pw##k)
  #define VFR(i) (bf16x8){vlo[i][0],vlo[i][1],vlo[i][2],vlo[i][3],vhi[i][0],vhi[i][1],vhi[i][2],vhi[i][3]}
  #define PIN(x) asm volatile("":"+v"(x))
  #define GAPA(MF,A0,A1,A2,A3,W0,W1,PW) do{ MF; sacc+=A0; sacc+=A1; sacc+=A2; sacc+=A3; PIN(sacc); W0; W1; PIN(PW); SBAR(); }while(0)
  #define EX(v) __builtin_amdgcn_exp2f(v)
  #define VOFF(m) (((((m)&1)+2*((m)>>3))*4096)+((((m)>>1)&3)*1024))
  #define VRD(m) do{ vlo[(m)&3]=vtr(vp_+VOFF(m)); vhi[(m)&3]=vtr(vp_+VOFF(m)+512); }while(0)
  #define GAPB(MF,RD,X,B) do{ MF; RD; X[B]=EX(X[B]); X[B+1]=EX(X[B+1]); PIN(X); SBAR(); }while(0)
  #define NORD do{}while(0)
  #define KRD(G,j,t) do{ if(G){ kload2(kf,kp0+KSL((t)+1),j); SBAR(); } }while(0)
  #define PVM(db,k,f) o[db]=__builtin_amdgcn_mfma_f32_32x32x16_bf16(PAF(k),VFR(f),o[db],0,0,0)
  #define PHA(C0,C1,P0,P1,t) do{ SBAR(); \
    const lds_cptr vp_=vp0+2*KSL((t)-1); const f32x16 z_=f32x16{}; \
    float sacc=(P0[0]+P0[1]); \
    GAPA(C0=__builtin_amdgcn_mfma_f32_32x32x16_bf16(kf[0],qr[0],z_,0,0,0), P0[2],P0[3],P0[4],P0[5],     pw0[0]=PKW(P0,0), pw0[1]=PKW(P0,2), pw0); \
    GAPA(C1=__builtin_amdgcn_mfma_f32_32x32x16_bf16(kf[1],qr[0],z_,0,0,0), P0[6],P0[7],P0[8],P0[9],     pw0[2]=PKW(P0,4), pw0[3]=PKW(P0,6), pw0); \
    GAPA(C0=__builtin_amdgcn_mfma_f32_32x32x16_bf16(kf[2],qr[1],C0,0,0,0),   P0[10],P0[11],P0[12],P0[13], pw1[0]=PKW(P0,8), pw1[1]=PKW(P0,10), pw1); \
    GAPA(C1=__builtin_amdgcn_mfma_f32_32x32x16_bf16(kf[3],qr[1],C1,0,0,0),   P0[14],P0[15],P1[0],P1[1],   pw1[2]=PKW(P0,12),pw1[3]=PKW(P0,14), pw1); \
    VRD(0); SBAR(); GAPA(C0=__builtin_amdgcn_mfma_f32_32x32x16_bf16(kf[4],qr[2],C0,0,0,0),   P1[2],P1[3],P1[4],P1[5],     pw2[0]=PKW(P1,0), pw2[1]=PKW(P1,2), pw2); \
    VRD(1); SBAR(); GAPA(C1=__builtin_amdgcn_mfma_f32_32x32x16_bf16(kf[5],qr[2],C1,0,0,0),   P1[6],P1[7],P1[8],P1[9],     pw2[2]=PKW(P1,4), pw2[3]=PKW(P1,6), pw2); \
    VRD(2); SBAR(); GAPA(C0=__builtin_amdgcn_mfma_f32_32x32x16_bf16(kf[6],qr[3],C0,0,0,0),   P1[10],P1[11],P1[12],P1[13], pw3[0]=PKW(P1,8), pw3[1]=PKW(P1,10), pw3); \
    VRD(3); SBAR(); GAPA(C1=__builtin_amdgcn_mfma_f32_32x32x16_bf16(kf[7],qr[3],C1,0,0,0),   P1[14],P1[15],0.f,0.f,       pw3[2]=PKW(P1,12),pw3[3]=PKW(P1,14), pw3); \
    l_reg+=sacc; SBAR(); }while(0)
  #define DMAI(t,GK,GV) do{ if(GK){DMA_K((t)+3);} if(GV){DMA_V((t)+1);} }while(0)
  #define PHB(C0,C1,t,GL) do{ SBAR(); CMASKB(C0,C1,t); \
    const lds_cptr vp_=vp0+2*KSL((t)-1); \
    GAPB(PVM(0,0,0), VRD(4), C0,0); \
    GAPB(PVM(1,0,1), VRD(5), C0,2); \
    GAPB(PVM(0,1,2), VRD(6), C0,4); \
    GAPB(PVM(1,1,3), VRD(7), C0,6); \
    KRD(GL,0,t); GAPB(PVM(0,2,0), VRD(8), C0,8); \
    GAPB(PVM(1,2,1), VRD(9), C0,10); \
    KRD(GL,1,t); GAPB(PVM(0,3,2), VRD(10), C0,12); \
    GAPB(PVM(1,3,3), VRD(11), C0,14); \
    KRD(GL,2,t); GAPB(PVM(2,0,0), VRD(12), C1,0); \
    GAPB(PVM(3,0,1), VRD(13), C1,2); \
    KRD(GL,3,t); GAPB(PVM(2,1,2), VRD(14), C1,4); \
    GAPB(PVM(3,1,3), VRD(15), C1,6); \
    GAPB(PVM(2,2,0), NORD, C1,8); \
    GAPB(PVM(3,2,1), NORD, C1,10); \
    GAPB(PVM(2,3,2), NORD, C1,12); \
    GAPB(PVM(3,3,3), NORD, C1,14); \
    }while(0)
  #define ENDW(tt) do{ if((tt)+3<NT){WAIT_BAR(3);} else if((tt)+2<NT){WAIT_BAR(2);} else {WAIT_BAR(0);} }while(0)
  if constexpr(!LATE){
    int t=1;
    #define CMASKB(P0,P1,t) do{}while(0)
    for(;t+5<NT;t+=2){
      PHA(pB0,pB1,pA0,pA1,t);   DMAI(t,true,true);   PHB(pB0,pB1,t,true);   WAIT_BAR(3);
      PHA(pA0,pA1,pB0,pB1,t+1); DMAI(t+1,true,true); PHB(pA0,pA1,t+1,true); WAIT_BAR(3);
    }
    #undef CMASKB
    #define CMASKB(P0,P1,t) CMASK(P0,P1,t)
    for(;t+1<NT;t+=2){
      PHA(pB0,pB1,pA0,pA1,t);   DMAI(t,(t+3<NT),(t+1<NT));   PHB(pB0,pB1,t,(t+1<NT));   ENDW(t);
      PHA(pA0,pA1,pB0,pB1,t+1); DMAI(t+1,(t+4<NT),(t+2<NT)); PHB(pA0,pA1,t+1,(t+2<NT)); ENDW(t+1);
    }
    PHA(pB0,pB1,pA0,pA1,NT-1); PHB(pB0,pB1,NT-1,false);
    #undef CMASKB
  } else {
    DMAI(1,(4<NT),(2<NT)); PHA(pB0,pB1,pA0,pA1,1); ENDW(1);
    int t=2;
    #define CMASKB(P0,P1,t) do{}while(0)
    for(;t+4<NT;t+=2){
      PHB(pB0,pB1,t-1,true); DMAI(t,true,true);   PHA(pA0,pA1,pB0,pB1,t);   WAIT_BAR(3);
      PHB(pA0,pA1,t,true);   DMAI(t+1,true,true); PHA(pB0,pB1,pA0,pA1,t+1); WAIT_BAR(3);
    }
    #undef CMASKB
    #define CMASKB(P0,P1,t) CMASK(P0,P1,t)
    for(;t+1<NT;t+=2){
      PHB(pB0,pB1,t-1,true);     DMAI(t,(t+3<NT),(t+1<NT));   PHA(pA0,pA1,pB0,pB1,t);   ENDW(t);
      PHB(pA0,pA1,t,(t+1<NT));   DMAI(t+1,(t+4<NT),(t+2<NT)); PHA(pB0,pB1,pA0,pA1,t+1); if(t+2<NT){ENDW(t+1);}
    }
    PHB(pB0,pB1,NT-1,false);
    #undef CMASKB
  }
  { float sacc=pB0[0]+pB0[1]; _Pragma("unroll") for(int r=2;r<16;++r)sacc+=pB0[r]; _Pragma("unroll") for(int r=0;r<16;++r)sacc+=pB1[r]; l_reg+=sacc;
    pw0=(u32x4){PKW(pB0,0),PKW(pB0,2),PKW(pB0,4),PKW(pB0,6)};pw1=(u32x4){PKW(pB0,8),PKW(pB0,10),PKW(pB0,12),PKW(pB0,14)};pw2=(u32x4){PKW(pB1,0),PKW(pB1,2),PKW(pB1,4),PKW(pB1,6)};pw3=(u32x4){PKW(pB1,8),PKW(pB1,10),PKW(pB1,12),PKW(pB1,14)};
    SBAR(); pv(o,vb0+2*KSL(NT-1),PAF(0),PAF(1),PAF(2),PAF(3)); }
  #undef PKW
  #undef PAF
  #undef VFR
  #undef PIN
  #undef GAPA
  #undef GAPB
  #undef NORD
  #undef PVM
  #undef VOFF
  #undef EX
  #undef VRD
  #undef KRD
  #undef PHA
  #undef PHB
  #undef DMAI
  #undef ENDW
  asm volatile("s_waitcnt lgkmcnt(0)\n\ts_barrier":::"memory");
  {auto rr=__builtin_amdgcn_permlane32_swap(__float_as_uint(l_reg),__float_as_uint(l_reg),false,false);l_reg=__uint_as_float(rr[0])+__uint_as_float(rr[1]);}
  if(hi==0)wsf[32+r32]=l_reg;asm volatile("s_waitcnt lgkmcnt(0)":::"memory");
  float rli[16];
  #pragma unroll
  for(int r=0;r<16;++r)rli[r]=__builtin_amdgcn_rcpf(wsf[32+crow(r,hi)]);
  bf16*Ow=Ob+(long)(q0+wid*QBLK)*PO;
  { bf16*stg=(bf16*)(shm+FOST)+wid*4096;
    #pragma unroll
    for(int r=0;r<16;++r){const int orow=crow(r,hi);
      #pragma unroll
      for(int d0=0;d0<4;++d0)stg[orow*128+d0*32+r32]=__float2bfloat16(o[d0][r]*rli[r]);}
    asm volatile("s_waitcnt lgkmcnt(0)":::"memory");
    #pragma unroll
    for(int i=0;i<8;++i){const int row=i*4+(lane>>4),ch=lane&15; const u32x4 v=*(const u32x4*)(stg+row*128+ch*8); ATTN_STORE16(Ow+(long)row*PO+ch*8,v);} }
  bool bad=false;
  { int* flg=(int*)(shm+FWS); asm volatile("s_waitcnt lgkmcnt(0)\n\ts_barrier":::"memory");
    if(tid==0)flg[0]=0; asm volatile("s_waitcnt lgkmcnt(0)\n\ts_barrier":::"memory");
    if(__any(!(l_reg>0x1p-60f&&l_reg<0x1p60f))&&lane==0)flg[0]=1; asm volatile("s_waitcnt lgkmcnt(0)\n\ts_barrier":::"memory");
    bad=flg[0]!=0; }
  asm volatile("s_waitcnt lgkmcnt(0)\n\ts_barrier":::"memory");
  #undef DMA_K
  #undef DMA_V
  #undef KSL
  #undef RFL
  #undef CMASK
  return bad;
}
constexpr int ATTN_LDS_BYTES=LDS_BYTES;
template<int THRL=8> __device__ __forceinline__ void attn_phase(char*lds,const bf16*Q,const bf16*K,const bf16*V,bf16*O,int vcu,int G){
  const int nun=(G==256)?3:(24*32+G-1)/G;
  for(int i=0;i<nun;++i){
    int vh,qb;
    if(G==256){ const int x=vcu>>5,j=vcu&31; vh=3*x+i; qb=(i==0)?j:(i==1)?((j<16)?j+16:j-16):((j<16)?31-2*j:62-2*j); }
    else { const int u=vcu+i*G; if(u>=24*32)break; vh=u>>5; qb=u&31; }
    const int b=vh/12,r=vh%12,h=r>>1,c=r&1;
    const long rb=(long)b*SEQ;
    const bool late=__builtin_amdgcn_readfirstlane((int)(threadIdx.x>>8))!=0;
    const bf16*Qp=Q+rb*PQ+h*128+c*64,*Kp=K+rb*PK+h*128+c*64,*Vp=V+rb*PV+h*128; bf16*Op=O+((long)c*BATCH*SEQ+rb)*PO+h*128;
    bool bad; if(late) bad=attn_unit_fast<true>(qb,Qp,Kp,Vp,Op,lds); else bad=attn_unit_fast<false>(qb,Qp,Kp,Vp,Op,lds);
    if(bad)
      attn_unit<THRL,false>(qb,Q+rb*PQ+h*128+c*64,K+rb*PK+h*128+c*64,V+rb*PV+h*128,O+((long)c*BATCH*SEQ+rb)*PO+h*128,lds);
  }
}
#undef SBAR
#undef WAIT_BAR
}
#include <hip/hip_cooperative_groups.h>
namespace cg = cooperative_groups;
#define GAS __attribute__((address_space(1)))
#define LAS __attribute__((address_space(3)))
typedef unsigned short bf16;
typedef unsigned v4u __attribute__((ext_vector_type(4)));
typedef unsigned v2u __attribute__((ext_vector_type(2)));
typedef float f32x4 __attribute__((ext_vector_type(4)));
typedef float f32x16 __attribute__((ext_vector_type(16)));
typedef short bf16x8 __attribute__((ext_vector_type(8)));
typedef short s16x4 __attribute__((ext_vector_type(4)));
#define LDS_WAIT() asm volatile("s_waitcnt lgkmcnt(0)" ::: "memory")

constexpr int NWAVES = 8, NTHR = 512;
constexpr int BATCH = 2, SEQ = 8192, T = BATCH * SEQ, D = 1024, FF = 2816, MIX = 768, NMEM = 256;
constexpr int PROJW = 3 * MIX + 256;
constexpr float EPS = 1e-6f;
constexpr float LAM_INIT = 0.35550906759096934f;
constexpr float C2 = 0.125f * 1.4426950408889634f;
constexpr size_t MiB = 1u << 20;
constexpr size_t WS_CTL = 0, WS_SSQ = 1 * MiB, WS_CS = 2 * MiB, WS_MEMB = 3 * MiB, WS_MEMKV = 4 * MiB, WS_SSQM = 5 * MiB, WS_W = 6 * MiB, WS_HB = 88 * MiB, WS_ACT = 120 * MiB, WS_KV = 208 * MiB, WS_END = 256 * MiB;
constexpr size_t WS_OB = 152 * MiB;
constexpr size_t W1_SZ = (size_t)2 * FF * D, W2_SZ = (size_t)D * FF;
constexpr size_t WO_W1_0 = 0, WO_W1_1 = W1_SZ, WO_KV = 2 * W1_SZ, WO_W1_2 = WO_KV + (size_t)1536 * D, WO_W1_3 = WO_W1_2 + W1_SZ, WO_W2 = WO_W1_3 + W1_SZ,
                 WO_AIN = WO_W2 + 4 * W2_SZ, WO_AOUT = WO_AIN + (size_t)PROJW * D, WO_Q = WO_AOUT + (size_t)D * D, WO_BOUT = WO_Q + (size_t)D * D, WO_MKV = WO_BOUT + (size_t)D * D, WO_END = WO_MKV + (size_t)2 * 512 * D;
static_assert(WO_END * 2 == 82 * MiB, "weights fill [6, 88) MiB");
constexpr int LDS_BYTES = 147456;

enum { K_PREP = 0, K_SWIGLU = 1, K_RES = 2, K_SCALE = 3, K_ROPE = 4, K_MIXA = 5, K_ATTN = 6, K_COMB = 7, K_FINAL = 8 };
struct Step { int kind, sync_after, M, N, K, ldc; float scale; int pad; int coff, tskip; const void* A; const void* Bt; void* p0; void* p1; void* p2; void* p3; };
constexpr int MAX_STEPS = 40;
struct Args { Step steps[MAX_STEPS]; const void* in[22]; float* out; unsigned char* ws; int lo, hi; };

__device__ __forceinline__ float bf_lo(unsigned w) { return __builtin_bit_cast(float, w << 16); }
__device__ __forceinline__ float bf_hi(unsigned w) { return __builtin_bit_cast(float, w & 0xffff0000u); }
__device__ __forceinline__ unsigned pk2(float lo, float hi) { return pg8::cvt_pk_bf16(lo, hi); }
__device__ __forceinline__ void st16_wt(void* p, const v4u v) { asm volatile("global_store_dwordx4 %0, %1, off sc1\n\ts_nop 1" :: "v"(p), "v"(v) : "memory"); }
__device__ __forceinline__ float wave_sum(float v) {
#pragma unroll
    for (int o = 1; o < 64; o <<= 1) v += __shfl_xor(v, o);
    return v;
}

struct WJob { const float* W; const float* gain; bf16* Wt; int K, N, mode; };
__device__ __forceinline__ void transpose_item(const WJob& J, LAS float* scr, int item, int lane) {
    const int nblk = J.N / 32, kb = item / nblk, nb = item % nblk, k0 = 64 * kb, n0d = 32 * nb;
    int n0s = n0d; bool perm = false;
    if (J.mode == 1) { const int pn = n0d >> 8, j = n0d & 255; n0s = (j < 128) ? (128 * pn + j) : (FF + 128 * pn + (j - 128)); }
    if (J.mode == 2) perm = (n0d < MIX) && ((n0d & 63) == 0);
    const int c = lane & 7;
    f32x4 g0 = (f32x4){1.f, 1.f, 1.f, 1.f}, g1 = g0;
    if (J.gain) { g0 = *(const f32x4*)(J.gain + k0 + 8 * c); g1 = *(const f32x4*)(J.gain + k0 + 8 * c + 4); }
    const float* src = J.W + (size_t)(k0 + (lane >> 5)) * J.N + n0s + (lane & 31);
    float v[32];
#pragma unroll
    for (int i = 0; i < 32; ++i) v[i] = __builtin_nontemporal_load(src + (size_t)(2 * i) * J.N);
#pragma unroll
    for (int i = 0; i < 32; ++i) scr[(2 * i + (lane >> 5)) * 33 + (lane & 31)] = v[i];
    LDS_WAIT(); asm volatile("" ::: "memory");
#pragma unroll
    for (int j = 0; j < 4; ++j) { const int n = (lane >> 3) + 8 * j; const int ns = (perm && n < 16) ? ((n & 1) ? 8 + (n >> 1) : (n >> 1)) : n;
        const LAS float* s = scr + (8 * c) * 33 + ns;
        v4u o; o.x = pk2(s[0 * 33] * g0[0], s[1 * 33] * g0[1]); o.y = pk2(s[2 * 33] * g0[2], s[3 * 33] * g0[3]); o.z = pk2(s[4 * 33] * g1[0], s[5 * 33] * g1[1]); o.w = pk2(s[6 * 33] * g1[2], s[7 * 33] * g1[3]);
        st16_wt(J.Wt + (size_t)(n0d + n) * J.K + k0 + 8 * c, o); }
    LDS_WAIT(); asm volatile("" ::: "memory");
}
__device__ __forceinline__ void row_to_bf16(const float* xrow, bf16* orow, float* ssqrow, int lane) {
    const f32x4* xr = (const f32x4*)xrow + 2 * lane; f32x4 v[4]; float s = 0.f;
#pragma unroll
    for (int j = 0; j < 4; ++j) { v[j] = __builtin_nontemporal_load(xr + (j & 1) + 128 * (j >> 1)); s += (v[j][0] * v[j][0] + v[j][1] * v[j][1]) + (v[j][2] * v[j][2] + v[j][3] * v[j][3]); }
    s = wave_sum(s);
#pragma unroll
    for (int h = 0; h < 2; ++h) { v4u w; w.x = pk2(v[2 * h][0], v[2 * h][1]); w.y = pk2(v[2 * h][2], v[2 * h][3]); w.z = pk2(v[2 * h + 1][0], v[2 * h + 1][1]); w.w = pk2(v[2 * h + 1][2], v[2 * h + 1][3]);
        st16_wt(orow + 8 * lane + 512 * h, w); }
    if (lane < 4) ssqrow[lane] = (lane == 0) ? s : 0.f;
}
typedef const __attribute__((address_space(4))) Args* ArgsP;
constexpr int I_W1 = (D / 64) * (2 * FF / 32), I_W2 = (FF / 64) * (D / 32), I_AIN = (D / 64) * (PROJW / 32), I_SQ = (D / 64) * (D / 32), I_KV = (D / 64) * (1536 / 32), I_MKV = (D / 64) * (512 / 32);
__device__ __forceinline__ int job_items(int j) { return j < 4 ? I_W1 : j < 8 ? I_W2 : j == 8 ? I_AIN : j == 10 ? I_KV : j < 13 ? I_SQ : j < 15 ? I_MKV : 0; }
__device__ __forceinline__ void convert_chunk(ArgsP ap, LAS float* scr, int gw, int NGW, int lane, int chunk) {
    typedef const float* cfp_t; const __attribute__((address_space(4))) cfp_t* in = (const __attribute__((address_space(4))) cfp_t*)ap->in;
    bf16* WB = (bf16*)(ap->ws + WS_W);
    const unsigned packed = chunk == 0 ? 0xED40u : chunk == 1 ? 0xA198u : chunk == 2 ? 0xCB25u : 0xF736u;
    const int j0 = packed & 15, j1 = (packed >> 4) & 15, j2 = (packed >> 8) & 15, j3 = (packed >> 12) & 15;
    const int n0 = job_items(j0), n1 = job_items(j1), n2 = job_items(j2), n3 = job_items(j3), total = n0 + n1 + n2 + n3;
    for (int it = gw; it < total; it += NGW) {
        int r = it, j = j0;
        if (r >= n0) { r -= n0; j = j1; if (r >= n1) { r -= n1; j = j2; if (r >= n2) { r -= n2; j = j3; } } }
        WJob J;
        if (j < 4) { const int l = j >> 1, post = j & 1;
            J.W = in[post ? 19 : 4] + (size_t)l * D * 2 * FF; J.gain = in[post ? 18 : 3] + l * D; J.Wt = WB + (j == 0 ? WO_W1_0 : j == 1 ? WO_W1_1 : j == 2 ? WO_W1_2 : WO_W1_3); J.K = D; J.N = 2 * FF; J.mode = 1; }
        else if (j < 8) { const int i = j - 4, l = i >> 1, post = i & 1;
            J.W = in[post ? 20 : 5] + (size_t)l * FF * D; J.gain = nullptr; J.Wt = WB + WO_W2 + (size_t)i * W2_SZ; J.K = FF; J.N = D; J.mode = 0; }
        else if (j == 8) { J.W = in[9]; J.gain = in[6]; J.Wt = WB + WO_AIN; J.K = D; J.N = PROJW; J.mode = 0; }
        else if (j == 9) { J.W = in[11]; J.gain = nullptr; J.Wt = WB + WO_AOUT; J.K = D; J.N = D; J.mode = 0; }
        else if (j == 10) { J.W = in[13]; J.gain = in[12]; J.Wt = WB + WO_KV; J.K = D; J.N = 1536; J.mode = 2; }
        else if (j == 11) { J.W = in[14]; J.gain = in[6] + D; J.Wt = WB + WO_Q; J.K = D; J.N = D; J.mode = 2; }
        else if (j == 12) { J.W = in[17]; J.gain = nullptr; J.Wt = WB + WO_BOUT; J.K = D; J.N = D; J.mode = 0; }
        else { const int l = j - 13; J.W = in[8] + (size_t)l * D * 512; J.gain = in[7] + l * D; J.Wt = WB + WO_MKV + (size_t)l * 512 * D; J.K = D; J.N = 512; J.mode = 0; }
        transpose_item(J, scr, r, lane);
    }
}
__device__ __forceinline__ void tail_convert(ArgsP ap, LAS unsigned char* lds, int M, int N, int G, int bx, int tid, int chunk, int tskip) {
    int rem = ((M / 256) * (N / 256)) % G;
    if (chunk <= 0 || rem == 0) return;
    rem += tskip; if (bx < rem || rem >= G) return;
    const int lane = tid & 63, wave = tid >> 6;
    convert_chunk(ap, (LAS float*)(lds + wave * 16384), (bx - rem) * NWAVES + wave, (G - rem) * NWAVES, lane, chunk);
    __syncthreads();
}
__device__ __forceinline__ void prep_phase(ArgsP ap, LAS unsigned char* lds, int vcu, int G, int tid) {
    const int lane = tid & 63, wave = tid >> 6;
    LAS float* scr = (LAS float*)(lds + wave * 16384);
    const int gw = vcu * NWAVES + wave, NGW = G * NWAVES;
    unsigned char* ws = ap->ws;
    typedef const float* cfp_t; const __attribute__((address_space(4))) cfp_t* in = (const __attribute__((address_space(4))) cfp_t*)ap->in;
    convert_chunk(ap, scr, gw, NGW, lane, 0);
    { const float* x = in[0]; bf16* hb = (bf16*)(ws + WS_HB); float* ssq = (float*)(ws + WS_SSQ);
      for (int m = gw; m < T; m += NGW) row_to_bf16(x + (size_t)m * D, hb + (size_t)m * D, ssq + (size_t)m * 4, lane);
      const float* mem = in[1]; bf16* mb = (bf16*)(ws + WS_MEMB); float* sm = (float*)(ws + WS_SSQM);
      for (int m = gw; m < BATCH * NMEM; m += NGW) row_to_bf16(mem + (size_t)m * D, mb + (size_t)m * D, sm + (size_t)m * 4, lane); }
    { const int* pos = (const int*)ap->in[2]; float* cs = (float*)(ws + WS_CS);
      for (int idx = vcu * NTHR + tid; idx < T * 8; idx += G * NTHR) { const int t = idx >> 3, i = idx & 7;
          const float invf = i == 0 ? 1.0f : i == 1 ? 0x1.8d275ep-3f : i == 2 ? 0x1.341190p-5f : i == 3 ? 0x1.ddee9cp-8f : i == 4 ? 0x1.72ba44p-10f : i == 5 ? 0x1.1f91f0p-12f : i == 6 ? 0x1.be2188p-15f : 0x1.5a0f4ep-17f;
          const float ang = (float)pos[t] * invf;
          double rev = (double)ang * 0.15915494309189533577; rev -= __builtin_floor(rev); const float f = (float)rev;
          cs[(size_t)t * 16 + i] = __builtin_amdgcn_cosf(f); cs[(size_t)t * 16 + 8 + i] = __builtin_amdgcn_sinf(f); } }
}

constexpr int MA_KS = 72, MA_VS = 264;
__device__ __forceinline__ void mem_attn_unit(LAS unsigned char* lds, const bf16* Q, int pq, const bf16* KV, bf16* Y, int py, int b, int h, int tb, int tid) {
    LAS bf16* Ks = (LAS bf16*)lds; LAS bf16* Vt = (LAS bf16*)(lds + 256 * MA_KS * 2);
    __syncthreads();
#pragma unroll
    for (int i = 0; i < 4; ++i) { const int idx = tid + NTHR * i, row = idx >> 3, chn = idx & 7;
        const bf16* src = KV + (size_t)(b * NMEM + row) * 512 + h * 64 + chn * 8;
        const v4u kk = *(const v4u*)src; *(LAS v4u*)(Ks + row * MA_KS + chn * 8) = kk;
        const v4u vv = *(const v4u*)(src + 256);
#pragma unroll
        for (int j = 0; j < 4; ++j) { Vt[(chn * 8 + 2 * j) * MA_VS + row] = (bf16)(vv[j] & 0xffffu); Vt[(chn * 8 + 2 * j + 1) * MA_VS + row] = (bf16)(vv[j] >> 16); } }
    __syncthreads();
    const int lane = tid & 63, wid = tid >> 6, r32 = lane & 31, hi = lane >> 5;
    const size_t t0 = (size_t)b * SEQ + tb * 256 + wid * 32;
    const bf16* qp = Q + (t0 + r32) * pq + h * 64 + hi * 8;
    bf16x8 qr[4];
#pragma unroll
    for (int d0 = 0; d0 < 4; ++d0) qr[d0] = *(const bf16x8*)(qp + d0 * 16);
    f32x16 s[8];
#pragma unroll
    for (int kb = 0; kb < 8; ++kb) { s[kb] = f32x16{};
#pragma unroll
        for (int d0 = 0; d0 < 4; ++d0) { const bf16x8 a = *(const LAS bf16x8*)(Ks + (kb * 32 + r32) * MA_KS + d0 * 16 + hi * 8); s[kb] = __builtin_amdgcn_mfma_f32_32x32x16_bf16(a, qr[d0], s[kb], 0, 0, 0); } }
    float mx = s[0][0];
#pragma unroll
    for (int kb = 0; kb < 8; ++kb)
#pragma unroll
        for (int r = 0; r < 16; ++r) mx = fmaxf(mx, s[kb][r]);
    mx = fmaxf(mx, __shfl_xor(mx, 32));
    const float mc = mx * C2; float l = 0.f;
    f32x16 o[2]; o[0] = f32x16{}; o[1] = f32x16{};
#pragma unroll
    for (int kb = 0; kb < 8; ++kb) {
#pragma unroll
        for (int r = 0; r < 16; ++r) { const float p = __builtin_amdgcn_exp2f(s[kb][r] * C2 - mc); s[kb][r] = p; l += p; }
#pragma unroll
        for (int s2 = 0; s2 < 2; ++s2) { v4u pw; pw.x = pk2(s[kb][8 * s2 + 0], s[kb][8 * s2 + 1]); pw.y = pk2(s[kb][8 * s2 + 2], s[kb][8 * s2 + 3]); pw.z = pk2(s[kb][8 * s2 + 4], s[kb][8 * s2 + 5]); pw.w = pk2(s[kb][8 * s2 + 6], s[kb][8 * s2 + 7]);
            const bf16x8 pb = __builtin_bit_cast(bf16x8, pw);
#pragma unroll
            for (int db = 0; db < 2; ++db) { const LAS bf16* vp = Vt + (db * 32 + r32) * MA_VS + kb * 32 + 16 * s2 + 4 * hi;
                const s16x4 lo = *(const LAS s16x4*)vp, hh = *(const LAS s16x4*)(vp + 8);
                const bf16x8 a = (bf16x8){lo[0], lo[1], lo[2], lo[3], hh[0], hh[1], hh[2], hh[3]};
                o[db] = __builtin_amdgcn_mfma_f32_32x32x16_bf16(a, pb, o[db], 0, 0, 0); } }
        __builtin_amdgcn_sched_barrier(0);
    }
    l += __shfl_xor(l, 32);
    const float inv = 1.0f / l;
    bf16* yp = Y + (t0 + r32) * py + h * 64 + 4 * hi;
#pragma unroll
    for (int db = 0; db < 2; ++db)
#pragma unroll
        for (int g = 0; g < 4; ++g) { v2u w; w.x = pk2(o[db][4 * g] * inv, o[db][4 * g + 1] * inv); w.y = pk2(o[db][4 * g + 2] * inv, o[db][4 * g + 3] * inv); *(v2u*)(yp + db * 32 + 8 * g) = w; }
}
__device__ __forceinline__ void mem_attn_phase(LAS unsigned char* lds, const bf16* Q, int pq, const bf16* KV, bf16* Y, int py, int vcu, int G, int tid) {
    for (int u = vcu; u < BATCH * 4 * (SEQ / 256); u += G) { const int tb = u & 31, h = (u >> 5) & 3, b = u >> 7; mem_attn_unit(lds, Q, pq, KV, Y, py, b, h, tb, tid); }
    __syncthreads();
}

__device__ __forceinline__ void unpack8(const v4u w, float* f) { f[0] = bf_lo(w.x); f[1] = bf_hi(w.x); f[2] = bf_lo(w.y); f[3] = bf_hi(w.y); f[4] = bf_lo(w.z); f[5] = bf_hi(w.z); f[6] = bf_lo(w.w); f[7] = bf_hi(w.w); }
__device__ __forceinline__ void conv_phase(const bf16* proj, bf16* y, const float* cw, int vcu, int G, int tid) {
    constexpr int RUN = 16, NCG = MIX / 8;
    for (int it = vcu * NTHR + tid; it < (T / RUN) * NCG; it += G * NTHR) {
        const int r = it / NCG, cg = it % NCG, t0 = r * RUN, ch = cg * 8;
        float w0[8], w1[8], w2[8], c1[8], c2[8];
#pragma unroll
        for (int i = 0; i < 8; ++i) { w0[i] = cw[ch + i]; w1[i] = cw[MIX + ch + i]; w2[i] = cw[2 * MIX + ch + i]; c1[i] = 0.f; c2[i] = 0.f; }
        if ((t0 & (SEQ - 1)) != 0) { float a[8], bq[8];
            const bf16* p2 = proj + (size_t)(t0 - 2) * PROJW + ch;
            unpack8(*(const v4u*)(p2 + MIX), a); unpack8(*(const v4u*)(p2 + 2 * MIX), bq);
#pragma unroll
            for (int i = 0; i < 8; ++i) c2[i] = a[i] * bq[i];
            unpack8(*(const v4u*)(p2 + PROJW + MIX), a); unpack8(*(const v4u*)(p2 + PROJW + 2 * MIX), bq);
#pragma unroll
            for (int i = 0; i < 8; ++i) c1[i] = a[i] * bq[i]; }
#pragma unroll 4
        for (int tt = 0; tt < RUN; ++tt) { const bf16* p = proj + (size_t)(t0 + tt) * PROJW + ch; float bg[8], cc[8], xx[8], o[8];
            unpack8(__builtin_nontemporal_load((const v4u*)p), bg); unpack8(__builtin_nontemporal_load((const v4u*)(p + MIX)), cc); unpack8(__builtin_nontemporal_load((const v4u*)(p + 2 * MIX)), xx);
#pragma unroll
            for (int i = 0; i < 8; ++i) { const float cx = cc[i] * xx[i]; o[i] = bg[i] * (w0[i] * c2[i] + w1[i] * c1[i] + w2[i] * cx); c2[i] = c1[i]; c1[i] = cx; }
            v4u w; w.x = pk2(o[0], o[1]); w.y = pk2(o[2], o[3]); w.z = pk2(o[4], o[5]); w.w = pk2(o[6], o[7]);
            st16_wt(y + (size_t)(t0 + tt) * D + ch, w); }
    }
}

__device__ __forceinline__ void combine_phase(const bf16* Ob, bf16* y, const float* lamp, const float* subln, int vcu, int G, int tid) {
    const int lane = tid & 63;
    const float d01 = wave_sum(lamp[lane] * lamp[64 + lane]), d23 = wave_sum(lamp[128 + lane] * lamp[192 + lane]);
    const float lam = expf(d01) - expf(d23) + LAM_INIT;
    const int sub = tid & 15, e = sub * 8;
    float gsub[8];
#pragma unroll
    for (int i = 0; i < 8; ++i) gsub[i] = subln[e + i] * (1.0f - LAM_INIT);
    for (int it = (vcu * NTHR + tid) >> 4; it < T * 6; it += (G * NTHR) >> 4) { const int t = it / 6, h = it % 6;
        const size_t off = (size_t)t * MIX + h * 128 + e; float a[8], bq[8], o[8]; float ss = 0.f;
        unpack8(__builtin_nontemporal_load((const v4u*)(Ob + off)), a); unpack8(__builtin_nontemporal_load((const v4u*)(Ob + (size_t)T * MIX + off)), bq);
#pragma unroll
        for (int i = 0; i < 8; ++i) { o[i] = a[i] - lam * bq[i]; ss += o[i] * o[i]; }
        ss += __shfl_xor(ss, 1); ss += __shfl_xor(ss, 2); ss += __shfl_xor(ss, 4); ss += __shfl_xor(ss, 8);
        const float rs = 1.0f / sqrtf(ss * (1.0f / 128.0f) + EPS);
        v4u w; w.x = pk2(o[0] * rs * gsub[0], o[1] * rs * gsub[1]); w.y = pk2(o[2] * rs * gsub[2], o[3] * rs * gsub[3]); w.z = pk2(o[4] * rs * gsub[4], o[5] * rs * gsub[5]); w.w = pk2(o[6] * rs * gsub[6], o[7] * rs * gsub[7]);
        st16_wt(y + (size_t)t * D + h * 128 + e, w); }
}
__device__ __forceinline__ void final_phase(float* out, const float* g, const bf16* hb, int vcu, int G, int tid) {
    const int lane = tid & 63, gw = vcu * NWAVES + (tid >> 6), NGW = G * NWAVES;
    f32x4 gv[4];
#pragma unroll
    for (int j = 0; j < 4; ++j) gv[j] = ((const f32x4*)g)[2 * lane + (j & 1) + 128 * (j >> 1)];
    for (int m = gw; m < T; m += NGW) { const v4u* hr = (const v4u*)(hb + (size_t)m * D) + lane; f32x4 v[4]; float s = 0.f;
#pragma unroll
        for (int j = 0; j < 2; ++j) { const v4u w = hr[64 * j]; v[2 * j] = (f32x4){bf_lo(w.x), bf_hi(w.x), bf_lo(w.y), bf_hi(w.y)}; v[2 * j + 1] = (f32x4){bf_lo(w.z), bf_hi(w.z), bf_lo(w.w), bf_hi(w.w)}; }
#pragma unroll
        for (int j = 0; j < 4; ++j) s += (v[j][0] * v[j][0] + v[j][1] * v[j][1]) + (v[j][2] * v[j][2] + v[j][3] * v[j][3]);
        const float rs = __builtin_amdgcn_rsqf(wave_sum(s) * (1.0f / D) + EPS);
        f32x4* orow = (f32x4*)(out + (size_t)m * D);
#pragma unroll
        for (int j = 0; j < 4; ++j) orow[2 * lane + (j & 1) + 128 * (j >> 1)] = v[j] * rs * gv[j]; }
}

#define RLX_AGENT __ATOMIC_RELAXED, __HIP_MEMORY_SCOPE_AGENT
#define XB_TMO      128
#define XB_XCNT(j)  (256  + 64 * (j))
#define XB_XSUB(j)  (1280 + 64 * (j))
#define XB_XGEN(j)  (2304 + 64 * (j))
#define XB_TOP      3328
#define XB_TOPGEN   3392
#define XCD_BAR_WORDS 3456
#define XB_SPIN_CAP (1u << 18)

__device__ __forceinline__ unsigned xb_ld(unsigned* p)              { return __hip_atomic_load(p, __ATOMIC_RELAXED, __HIP_MEMORY_SCOPE_AGENT); }
__device__ __forceinline__ unsigned xb_add(unsigned* p, unsigned v) { return __hip_atomic_fetch_add(p, v, __ATOMIC_RELAXED, __HIP_MEMORY_SCOPE_AGENT); }
__device__ __forceinline__ unsigned xb_xcc_id() { return (unsigned)__builtin_amdgcn_s_getreg((3 << 11) | 20) & 0xFu; }
#define XB_SPIN(cond, bar) do { unsigned _sp = 0; while (cond) { __builtin_amdgcn_s_sleep(1); \
    if ((++_sp & 255u) == 0u) { if (xb_ld(&(bar)[XB_TMO])) break; if (_sp > XB_SPIN_CAP) { atomicAdd(&(bar)[XB_TMO], 1u); break; } } } } while (0)

struct XcdBarrier {
    unsigned* bar; unsigned x;
    volatile LAS unsigned* st;
};

__device__ __forceinline__ XcdBarrier xcd_barrier_post(unsigned* bar, volatile LAS unsigned* st) {
    XcdBarrier b; b.bar = bar; b.x = xb_xcc_id(); b.st = st;
    if (threadIdx.x == 0) (void)xb_add(&bar[XB_XCNT(b.x)], 1u);
    return b;
}
__device__ __forceinline__ void xcd_barrier_complete(unsigned* bar, unsigned x, unsigned& nloc, unsigned& nx) {
    const unsigned G = gridDim.x * gridDim.y * gridDim.z;
    unsigned sum, cnt, mine, sp = 0u;
    for (;;) {
        sum = 0u; cnt = 0u; mine = 0u;
#pragma unroll
        for (unsigned j = 0; j < 16; ++j) { const unsigned c = xb_ld(&bar[XB_XCNT(j)]); sum += c; cnt += (c > 0u) ? 1u : 0u; mine = (j == x) ? c : mine; }
        if (sum == G) break;
        __builtin_amdgcn_s_sleep(1);
        if ((++sp & 255u) == 0u) { if (xb_ld(&bar[XB_TMO])) break; if (sp > XB_SPIN_CAP) { atomicAdd(&bar[XB_TMO], 1u); break; } }
    }
    nloc = mine > 0u ? mine : 1u; nx = cnt > 0u ? cnt : 1u;
}

__device__ __forceinline__ void xcd_barrier(const XcdBarrier& b) {
    asm volatile("s_waitcnt vmcnt(0)" ::: "memory");
    __syncthreads();
    if (threadIdx.x == 0) {
        unsigned* bar = b.bar;
        __builtin_amdgcn_s_waitcnt(0);
        unsigned nloc = b.st[0], nx = b.st[1];
        if (nloc == 0u) { xcd_barrier_complete(bar, b.x, nloc, nx); b.st[0] = nloc; b.st[1] = nx; }
        const unsigned old = xb_add(&bar[XB_XSUB(b.x)], 1u);
        const unsigned gen = old / nloc;
        if (old + 1u == (gen + 1u) * nloc) {
            __builtin_amdgcn_fence(__ATOMIC_RELEASE, "agent");
            asm volatile("s_waitcnt vmcnt(0)" ::: "memory");
            const unsigned og = xb_add(&bar[XB_TOP], 1u);
            const unsigned tg = og / nx;
            if (og + 1u == (tg + 1u) * nx) xb_add(&bar[XB_TOPGEN], 1u);
            else XB_SPIN(xb_ld(&bar[XB_TOPGEN]) == tg, bar);
            xb_add(&bar[XB_XGEN(b.x)], 1u);
            __builtin_amdgcn_fence(__ATOMIC_ACQUIRE, "agent");
            asm volatile("s_waitcnt vmcnt(0)" ::: "memory");
        } else {
            XB_SPIN(xb_ld(&bar[XB_XGEN(b.x)]) == gen, bar);
            __builtin_amdgcn_fence(__ATOMIC_ACQUIRE, "agent");
            asm volatile("s_waitcnt vmcnt(0)" ::: "memory");
        }
    }
    __syncthreads();
}

__global__ void __launch_bounds__(NTHR, 2) mk_fwd(Args args) {
    extern __shared__ __attribute__((aligned(16))) unsigned char lds_raw[];
    LAS unsigned char* lds = (LAS unsigned char*)lds_raw;
    const int G = gridDim.x, bx = blockIdx.x;
    const int vcu = (G % 8 == 0) ? (bx % 8) * (G / 8) + bx / 8 : bx;
    volatile LAS unsigned* bst = (volatile LAS unsigned*)(lds + LDS_BYTES - 64);
    if (threadIdx.x < 2) bst[threadIdx.x] = 0u;
    __syncthreads();
    const XcdBarrier bar = xcd_barrier_post((unsigned*)args.ws, bst);
    const int s_lo = args.lo, s_hi = args.hi;
    for (int si = s_lo; si < s_hi; ++si) {
        ArgsP ap = (ArgsP)__builtin_amdgcn_kernarg_segment_ptr(); asm volatile("" : "+s"(ap));
        const __attribute__((address_space(4))) Step& st = ap->steps[si];
        int tid = threadIdx.x; asm volatile("" : "+v"(tid));
        const int kind = st.kind;
#ifndef MK_KMASK
#define MK_KMASK 0x1ff
#endif
#define KON(k) ((MK_KMASK >> (k)) & 1)
        if (KON(K_PREP) && kind == K_PREP) prep_phase(ap, lds, vcu, G, tid);
        else if (KON(K_SWIGLU) && kind == K_SWIGLU) { pg8::Gemm g{(const pg8::bf16_t*)st.A, (const pg8::bf16_t*)st.Bt, st.M, st.N, st.K}; pg8::StaticOrder S; S.init(st.M, st.N, G, bx);
            pg8::EpiSwiGLU E{(pg8::bf16_t*)st.p0, st.ldc, (const float*)st.p1, st.pad, (pg8::bf16_t*)st.p2, 1536, (const float*)st.p3}; pg8::gemm_phase<pg8::EpiSwiGLU, pg8::StaticOrder, true, true>(lds, g, S, E); tail_convert(ap, lds, st.M, st.N, G, bx, tid, (int)st.scale, st.tskip); }
        else if (KON(K_RES) && kind == K_RES) { pg8::Gemm g{(const pg8::bf16_t*)st.A, (const pg8::bf16_t*)st.Bt, st.M, st.N, st.K}; pg8::StaticOrder S; S.init(st.M, st.N, G, bx);
            pg8::EpiRes E{(pg8::bf16_t*)st.p2, (float*)st.p3, st.scale, (PG8_LAS float*)(lds + 131072)}; pg8::gemm_phase<pg8::EpiRes, pg8::StaticOrder, true, true>(lds, g, S, E); }
        else if (KON(K_SCALE) && kind == K_SCALE) { pg8::Gemm g{(const pg8::bf16_t*)st.A, (const pg8::bf16_t*)st.Bt, st.M, st.N, st.K}; pg8::StaticOrder S; S.init(st.M, st.N, G, (bx - st.coff + G) % G);
            pg8::EpiScale E{(pg8::bf16_t*)st.p0, st.ldc, (const float*)st.p1}; pg8::gemm_phase<pg8::EpiScale, pg8::StaticOrder, true, true>(lds, g, S, E); tail_convert(ap, lds, st.M, st.N, G, bx, tid, (int)st.scale, st.tskip); }
        else if (KON(K_ROPE) && kind == K_ROPE) { pg8::Gemm g{(const pg8::bf16_t*)st.A, (const pg8::bf16_t*)st.Bt, st.M, st.N, st.K}; pg8::StaticOrder S; S.init(st.M, st.N, G, bx);
            pg8::EpiRope E{(pg8::bf16_t*)st.p0, st.ldc, (const float*)st.p1, (const float*)st.p2, st.scale}; pg8::gemm_phase<pg8::EpiRope, pg8::StaticOrder, true, true>(lds, g, S, E); }
        else if (KON(K_MIXA) && kind == K_MIXA) { conv_phase((const bf16*)st.A, (bf16*)st.p0, (const float*)st.p1, vcu, G, tid);
            mem_attn_phase(lds, (const bf16*)st.A + 3 * MIX, PROJW, (const bf16*)st.p2, (bf16*)st.p0 + MIX, D, vcu, G, tid); }
        else if (KON(K_ATTN) && kind == K_ATTN) { attn_body::attn_phase<8>((char*)lds_raw, (const attn_body::bf16*)st.A, (const attn_body::bf16*)st.Bt, (const attn_body::bf16*)st.Bt + MIX, (attn_body::bf16*)st.p0, vcu, G); }
        else if (KON(K_COMB) && kind == K_COMB) { combine_phase((const bf16*)st.A, (bf16*)st.p0, (const float*)st.p1, (const float*)st.p2, vcu, G, tid);
            mem_attn_phase(lds, (const bf16*)st.p0 + MIX, D, (const bf16*)st.p3, (bf16*)st.p0 + MIX, D, vcu, G, tid); }
        else if (KON(K_FINAL) && kind == K_FINAL) final_phase((float*)st.p0, (const float*)st.p1, (const bf16*)st.p2, vcu, G, tid);
        if (st.sync_after && si + 1 < s_hi) xcd_barrier(bar);
    }
}

#ifndef MK_ONE_LAUNCH
#define MK_ONE_LAUNCH 1
#endif
extern "C" void kernel_launch(void* const* d_in, const int* in_sizes, int n_in, void* d_out, int out_size, void* d_ws, size_t ws_size, hipStream_t stream) {
    static int grid = 0;
    if (grid == 0) {
        if (n_in != 22 || in_sizes[0] != T * D || out_size != T * D || ws_size < WS_END) { fprintf(stderr, "kernel_launch: unexpected problem (n_in %d, in0 %d, out %d, ws %zu)\n", n_in, n_in > 0 ? in_sizes[0] : -1, out_size, ws_size); grid = -1; return; }
        int dev = 0, cus = 0, per_cu = 0;
        if (hipGetDevice(&dev) != hipSuccess || hipDeviceGetAttribute(&cus, hipDeviceAttributeMultiprocessorCount, dev) != hipSuccess) { grid = -1; return; }
        if (hipFuncSetAttribute((const void*)mk_fwd, hipFuncAttributeMaxDynamicSharedMemorySize, LDS_BYTES) != hipSuccess) { fprintf(stderr, "kernel_launch: hipFuncSetAttribute failed\n"); grid = -1; return; }
        if (hipOccupancyMaxActiveBlocksPerMultiprocessor(&per_cu, (const void*)mk_fwd, NTHR, LDS_BYTES) != hipSuccess || per_cu < 1) { fprintf(stderr, "kernel_launch: occupancy query says %d\n", per_cu); per_cu = 1; }
        (void)hipGetLastError();
        grid = cus;
    }
    if (grid < 0) return;
    unsigned char* ws = (unsigned char*)d_ws; bf16* WB = (bf16*)(ws + WS_W);
    bf16* hb = (bf16*)(ws + WS_HB); bf16* act = (bf16*)(ws + WS_ACT); bf16* kvb = (bf16*)(ws + WS_KV); bf16* y0 = (bf16*)(ws + WS_KV); bf16* qb = (bf16*)(ws + WS_ACT); bf16* ob = (bf16*)(ws + WS_OB);
    float* ssq = (float*)(ws + WS_SSQ); float* cs = (float*)(ws + WS_CS); bf16* memb = (bf16*)(ws + WS_MEMB); bf16* memkv = (bf16*)(ws + WS_MEMKV); float* ssqm = (float*)(ws + WS_SSQM);
    float* out = (float*)d_out;
    Args a{}; int n = 0;
    auto add = [&](int kind, int sync, int M, int N, int K, int ldc, float scale, const void* A, const void* Bt, void* p0, void* p1, void* p2, void* p3) {
        Step& s = a.steps[n++]; s.kind = kind; s.sync_after = sync; s.M = M; s.N = N; s.K = K; s.ldc = ldc; s.scale = scale; s.pad = 0; s.coff = 0; s.tskip = 0; s.A = A; s.Bt = Bt; s.p0 = p0; s.p1 = p1; s.p2 = p2; s.p3 = p3; };
    add(K_PREP, 1, 0, 0, 0, 0, 0.f, nullptr, nullptr, nullptr, nullptr, nullptr, nullptr);
    add(K_SCALE, 0, 512, 512, D, 512, 0.f, memb, WB + WO_MKV, memkv, ssqm, nullptr, nullptr); a.steps[n - 1].coff = 128;
    add(K_SCALE, 0, 512, 512, D, 512, 0.f, memb, WB + WO_MKV + (size_t)512 * D, memkv + 512 * 512, ssqm, nullptr, nullptr); a.steps[n - 1].coff = 132;
    add(K_SWIGLU, 1, T, 2 * FF, D, FF, 1.f, hb, WB + WO_W1_0, act, ssq, nullptr, nullptr); a.steps[n - 1].tskip = 8;
    add(K_RES, 1, T, D, FF, D, 0.5f, act, WB + WO_W2, nullptr, nullptr, hb, ssq);
    add(K_SCALE, 1, T, PROJW, D, PROJW, 2.f, hb, WB + WO_AIN, act, ssq, nullptr, nullptr);
    add(K_MIXA, 1, 0, 0, 0, 0, 0.f, act, nullptr, y0, (void*)d_in[10], memkv, nullptr);
    add(K_RES, 1, T, D, D, D, 1.0f, y0, WB + WO_AOUT, nullptr, nullptr, hb, ssq);
    add(K_SWIGLU, 1, T, 2 * FF, D, FF, 3.f, hb, WB + WO_W1_1, act, ssq, nullptr, nullptr);
    add(K_RES, 1, T, D, FF, D, 0.5f, act, WB + WO_W2 + W2_SZ, nullptr, nullptr, hb, ssq);
    add(K_SWIGLU, 1, T, 1536 + 2 * FF, D, FF, 0.f, hb, WB + WO_KV, act, ssq, kvb, cs); a.steps[n - 1].pad = 6;
    add(K_RES, 1, T, D, FF, D, 0.5f, act, WB + WO_W2 + 2 * W2_SZ, nullptr, nullptr, hb, ssq);
    add(K_ROPE, 1, T, D, D, D, C2, hb, WB + WO_Q, qb, ssq, cs, nullptr);
    add(K_ATTN, 1, 0, 0, 0, 0, 0.f, qb, kvb, ob, nullptr, nullptr, nullptr);
    add(K_COMB, 1, 0, 0, 0, 0, 0.f, ob, nullptr, qb, (void*)d_in[15], (void*)d_in[16], memkv + 512 * 512);
    add(K_RES, 1, T, D, D, D, 1.0f, qb, WB + WO_BOUT, nullptr, nullptr, hb, ssq);
    add(K_SWIGLU, 1, T, 2 * FF, D, FF, 0.f, hb, WB + WO_W1_3, act, ssq, nullptr, nullptr);
    add(K_RES, 1, T, D, FF, D, 0.5f, act, WB + WO_W2 + 3 * W2_SZ, nullptr, nullptr, hb, ssq);
    add(K_FINAL, 0, 0, 0, 0, 0, 0.f, nullptr, nullptr, out, (void*)d_in[21], hb, nullptr);
#ifndef MK_REPMASK
#define MK_REPMASK 0
#endif
#ifndef MK_EXTRASYNC
#define MK_EXTRASYNC 0
#endif
    if (MK_REPMASK || MK_EXTRASYNC) {
        Step tmp[MAX_STEPS]; int m = 0;
        for (int i = 0; i < n; ++i) { tmp[m++] = a.steps[i];
            if ((MK_REPMASK >> i) & 1) { if (!a.steps[i].sync_after) { tmp[m - 1].sync_after = 1; } Step d = a.steps[i]; d.sync_after = 1; if (d.kind == K_RES) { d.scale = 0.f; } tmp[m++] = d; }
            if (i == 5) for (int q = 0; q < MK_EXTRASYNC; ++q) { Step d{}; d.kind = 99; d.sync_after = 1; tmp[m++] = d; } }
        n = m; for (int i = 0; i < n; ++i) a.steps[i] = tmp[i];
    }
    for (int i = 0; i < 22; ++i) a.in[i] = d_in[i];
    a.out = out; a.ws = ws;
    if (hipMemsetAsync(ws + WS_CTL, 0, 16384, stream) != hipSuccess) { fprintf(stderr, "kernel_launch: memset failed\n"); return; }
#if MK_ONE_LAUNCH
    a.lo = 0; a.hi = n;
    void* kargs[] = {&a};
    hipError_t e = hipLaunchCooperativeKernel((const void*)mk_fwd, dim3(grid), dim3(NTHR), kargs, LDS_BYTES, stream);
    if (e != hipSuccess) fprintf(stderr, "kernel_launch: cooperative launch failed: %s\n", hipGetErrorString(e));
#else
    for (int lo = 0; lo < n;) { int hi = lo; while (hi < n && !a.steps[hi].sync_after) ++hi; if (hi < n) ++hi;
        a.lo = lo; a.hi = hi; hipLaunchKernelGGL(mk_fwd, dim3(grid), dim3(NTHR), LDS_BYTES, stream, a); lo = hi; }
#endif
}
```

```cpp
#include <hip/hip_runtime.h>
#include <cstdio>
#include <cstdint>
namespace pg8 {
#define PG8_LAS __attribute__((address_space(3)))
typedef unsigned short bf16_t;
typedef short bf16x8 __attribute__((ext_vector_type(8)));
typedef float f32x4 __attribute__((ext_vector_type(4)));
typedef unsigned u32x4 __attribute__((ext_vector_type(4)));
constexpr int BM = 256, BK = 64, HALF = 128, HTB = HALF * BK * 2  , STAGE_BYTES = 8 * HTB, NXCD = 8, WGM = 8;

__host__ __device__ __forceinline__ int lds_byte(int r, int c) { const int st = (r >> 4) * 2 + (c >> 5), rr = r & 15, cc = c & 31, ob = rr * 64 + cc * 2; return st * 1024 + (ob ^ (((ob >> 9) & 1) << 5)); }
__host__ __device__ __forceinline__ void stage_rc(int b, int& R, int& C) { const int st = b / 1024, sb = b % 1024, swz = sb ^ (((sb >> 9) & 1) << 5); R = (st >> 1) * 16 + swz / 64; C = (st & 1) * 32 + (swz % 64) / 2; }
__host__ __device__ __forceinline__ int perm32(int rho) { const int n = rho >> 4, i = rho & 15; return 8 * (i >> 2) + 4 * n + (i & 3); }

struct Unit { int pm, pn; };
struct Gemm { const bf16_t* A; const bf16_t* Bt; int M, N, K; };

struct StaticOrder {
    int nM, nN, nwg, G, c;
    __host__ __device__ void init(int M, int N, int G_, int c_) { nM = M / BM; nN = N / BM; nwg = nM * nN; G = G_; c = c_; }
    __host__ __device__ bool next(int i, Unit& u) const {
        const long L = (long)i * G + c; if (L >= nwg) return false;
        int wgid = (int)L; { const int q = nwg / NXCD, r = nwg % NXCD, xcd = wgid % NXCD, off = wgid / NXCD; wgid = (xcd < r ? xcd * (q + 1) : r * (q + 1) + (xcd - r) * q) + off; }
        const int nig = WGM * nN, gid = wgid / nig, fm = gid * WGM, gsz = (nM - fm) < WGM ? (nM - fm) : WGM;
        u.pm = fm + ((wgid % nig) % gsz); u.pn = (wgid % nig) / gsz; return true;
    }
    __device__ __forceinline__ void a_ready(const Unit&) const {}
    __device__ __forceinline__ void done(const Unit&) const {}
};
typedef float f32x2 __attribute__((ext_vector_type(2))); typedef __bf16 bf16x2_t __attribute__((ext_vector_type(2)));
__device__ __forceinline__ unsigned cvt_pk_bf16(float lo, float hi) { const f32x2 v = {lo, hi}; const bf16x2_t b = __builtin_convertvector(v, bf16x2_t); return __builtin_bit_cast(unsigned, b); }
constexpr float RMS_EPS = 1e-6f;
__device__ __forceinline__ void prefetch_stats(float (&pre)[8], const float* ssq, const Unit& u, int wr, int fr, int fq) {
    const float* p = ssq + (size_t)(u.pm * BM + wr * 64 + fr) * 4 + fq;
#pragma unroll
    for (int ai = 0; ai < 2; ++ai)
#pragma unroll
        for (int m = 0; m < 4; ++m) pre[ai * 4 + m] = p[(size_t)(ai * HALF + m * 16) * 4];
}
__device__ __forceinline__ float row_rstd(float part) {
    float s = part; s += __shfl_xor(s, 16); s += __shfl_xor(s, 32);
    return __builtin_amdgcn_rsqf(s * (1.0f / 1024.0f) + RMS_EPS);
}
__device__ __forceinline__ float silu_mul(float g, float u) { return g * u * __builtin_amdgcn_rcpf(1.0f + __builtin_amdgcn_exp2f(-1.4426950408889634f * g)); }
__device__ __forceinline__ void store16_wt(void* p, const u32x4 v) { asm volatile("global_store_dwordx4 %0, %1, off sc1\n\ts_nop 1" :: "v"(p), "v"(v) : "memory"); }
__device__ __forceinline__ u32x4 pack8(const f32x4 v0, const f32x4 v1) { u32x4 w; w.x = cvt_pk_bf16(v0[0], v0[1]); w.y = cvt_pk_bf16(v0[2], v0[3]); w.z = cvt_pk_bf16(v1[0], v1[1]); w.w = cvt_pk_bf16(v1[2], v1[3]); return w; }

struct EpiSwiGLU {
    static constexpr bool PERM = true, AFTER_DRAIN = false;
    bf16_t* O; int ldc; const float* ssq; int npre; bf16_t* O2; int ld2; const float* cs;
    __device__ __forceinline__ void prefetch(float (&pre)[8], const Unit& u, int wr, int fr, int fq) const { prefetch_stats(pre, ssq, u, wr, fr, fq); }
    __device__ __forceinline__ void operator()(const f32x4 (&acc)[2][2][4][2], const Unit& u, int wr, int wc, int fr, int fq, const float (&pre)[8]) const {
        const int row0 = u.pm * BM + wr * 64 + fr;
        if (u.pn < npre) {
            const int col0 = u.pn * BM + wc * 32 + 8 * fq; const bool rot = (u.pn < 3) && ((wc & 1) == 0) && (fq < 2);
#pragma unroll
            for (int ai = 0; ai < 2; ++ai)
#pragma unroll
                for (int m = 0; m < 4; ++m) { const int row = row0 + ai * HALF + m * 16; const float rs = row_rstd(pre[ai * 4 + m]);
                    f32x4 c4 = (f32x4){1.f, 1.f, 1.f, 1.f}, s4 = (f32x4){0.f, 0.f, 0.f, 0.f};
                    if (rot) { c4 = *(const f32x4*)(cs + (size_t)row * 16 + 4 * fq); s4 = *(const f32x4*)(cs + (size_t)row * 16 + 8 + 4 * fq); }
#pragma unroll
                    for (int bj = 0; bj < 2; ++bj) { const f32x4 v0 = acc[ai][bj][m][0] * rs, v1 = acc[ai][bj][m][1] * rs; f32x4 o0, o1;
                        o0[0] = v0[0] * c4[0] - v0[1] * s4[0]; o0[1] = v0[1] * c4[0] + v0[0] * s4[0]; o0[2] = v0[2] * c4[1] - v0[3] * s4[1]; o0[3] = v0[3] * c4[1] + v0[2] * s4[1];
                        o1[0] = v1[0] * c4[2] - v1[1] * s4[2]; o1[1] = v1[1] * c4[2] + v1[0] * s4[2]; o1[2] = v1[2] * c4[3] - v1[3] * s4[3]; o1[3] = v1[3] * c4[3] + v1[2] * s4[3];
                        store16_wt(O2 + (size_t)row * ld2 + col0 + bj * HALF, pack8(o0, o1)); } }
            return;
        }
        const int col0 = (u.pn - npre) * HALF + wc * 32 + 8 * fq;
#pragma unroll
        for (int ai = 0; ai < 2; ++ai)
#pragma unroll
            for (int m = 0; m < 4; ++m) { const int row = row0 + ai * HALF + m * 16; const float rs = row_rstd(pre[ai * 4 + m]), nt = rs * -1.4426950408889634f;
                f32x4 o[2];
#pragma unroll
                for (int n = 0; n < 2; ++n) { const f32x4 g = acc[ai][0][m][n], uu = acc[ai][1][m][n]; const f32x4 t = g * nt; f32x4 e;
                    e[0] = __builtin_amdgcn_exp2f(t[0]); e[1] = __builtin_amdgcn_exp2f(t[1]); e[2] = __builtin_amdgcn_exp2f(t[2]); e[3] = __builtin_amdgcn_exp2f(t[3]);
                    const f32x4 d = e + 1.0f; f32x4 r;
                    r[0] = __builtin_amdgcn_rcpf(d[0]); r[1] = __builtin_amdgcn_rcpf(d[1]); r[2] = __builtin_amdgcn_rcpf(d[2]); r[3] = __builtin_amdgcn_rcpf(d[3]);
                    o[n] = ((g * rs) * r) * (uu * rs); }
                store16_wt(O + (size_t)row * ldc + col0, pack8(o[0], o[1])); }
    }
};
__device__ __forceinline__ float bfl(unsigned w) { return __builtin_bit_cast(float, w << 16); }
__device__ __forceinline__ float bfh(unsigned w) { return __builtin_bit_cast(float, w & 0xffff0000u); }
struct EpiRes {
    static constexpr bool PERM = true, AFTER_DRAIN = false;
    bf16_t* hb; float* ssq; float scale; PG8_LAS float* red;
    __device__ __forceinline__ void prefetch(float (&pre)[8], const Unit&, int, int, int) const {}
    __device__ __forceinline__ void operator()(const f32x4 (&acc)[2][2][4][2], const Unit& u, int wr, int wc, int fr, int fq, const float (&pre)[8]) const {
        const int rl0 = wr * 64 + fr, row0 = u.pm * BM + rl0, col0 = u.pn * BM + wc * 32 + 8 * fq;
#pragma unroll
        for (int ai = 0; ai < 2; ++ai)
#pragma unroll
            for (int m = 0; m < 4; ++m) { const int row = row0 + ai * HALF + m * 16; bf16_t* p = hb + (size_t)row * 1024 + col0; float ss = 0.f;
#pragma unroll
                for (int bj = 0; bj < 2; ++bj) { const u32x4 w = *(const u32x4*)(p + bj * HALF);
                    const f32x4 b0 = (f32x4){bfl(w.x), bfh(w.x), bfl(w.y), bfh(w.y)}, b1 = (f32x4){bfl(w.z), bfh(w.z), bfl(w.w), bfh(w.w)};
                    const f32x4 o0 = b0 + acc[ai][bj][m][0] * scale, o1 = b1 + acc[ai][bj][m][1] * scale;
                    store16_wt(p + bj * HALF, pack8(o0, o1));
                    const f32x4 q = o0 * o0 + o1 * o1; ss += (q[0] + q[1]) + (q[2] + q[3]); }
                ss += __shfl_xor(ss, 16); ss += __shfl_xor(ss, 32);
                if (fq == 0) red[(rl0 + ai * HALF + m * 16) * 4 + wc] = ss; }
        asm volatile("s_waitcnt lgkmcnt(0)" ::: "memory"); __builtin_amdgcn_s_barrier(); asm volatile("" ::: "memory");
        const int tid = (wr * 4 + wc) * 64 + fq * 16 + fr;
        if (tid < BM) { const f32x4 v = *(const PG8_LAS f32x4*)(red + tid * 4); ssq[(size_t)(u.pm * BM + tid) * 4 + u.pn] = (v[0] + v[1]) + (v[2] + v[3]); }
        asm volatile("s_waitcnt lgkmcnt(0)" ::: "memory"); __builtin_amdgcn_s_barrier(); asm volatile("" ::: "memory");
    }
};
struct EpiScale {
    static constexpr bool PERM = true, AFTER_DRAIN = false;
    bf16_t* O; int ldc; const float* ssq;
    __device__ __forceinline__ void prefetch(float (&pre)[8], const Unit& u, int wr, int fr, int fq) const { prefetch_stats(pre, ssq, u, wr, fr, fq); }
    __device__ __forceinline__ void operator()(const f32x4 (&acc)[2][2][4][2], const Unit& u, int wr, int wc, int fr, int fq, const float (&pre)[8]) const {
        const int row0 = u.pm * BM + wr * 64 + fr, col0 = u.pn * BM + wc * 32 + 8 * fq;
#pragma unroll
        for (int ai = 0; ai < 2; ++ai)
#pragma unroll
            for (int m = 0; m < 4; ++m) { const int row = row0 + ai * HALF + m * 16; const float rs = row_rstd(pre[ai * 4 + m]);
#pragma unroll
                for (int bj = 0; bj < 2; ++bj) store16_wt(O + (size_t)row * ldc + col0 + bj * HALF, pack8(acc[ai][bj][m][0] * rs, acc[ai][bj][m][1] * rs)); }
    }
};
struct EpiRope {
    static constexpr bool PERM = true, AFTER_DRAIN = false;
    bf16_t* O; int ldc; const float* ssq; const float* cs; float rscale;
    __device__ __forceinline__ void prefetch(float (&pre)[8], const Unit& u, int wr, int fr, int fq) const { prefetch_stats(pre, ssq, u, wr, fr, fq); }
    __device__ __forceinline__ void operator()(const f32x4 (&acc)[2][2][4][2], const Unit& u, int wr, int wc, int fr, int fq, const float (&pre)[8]) const {
        const int row0 = u.pm * BM + wr * 64 + fr, col0 = u.pn * BM + wc * 32 + 8 * fq;
        const bool ropet = u.pn < 3, rot = ropet && ((wc & 1) == 0) && (fq < 2);
        const float sc = ropet ? rscale : 1.0f;
#pragma unroll
        for (int ai = 0; ai < 2; ++ai)
#pragma unroll
            for (int m = 0; m < 4; ++m) { const int row = row0 + ai * HALF + m * 16; const float rs = row_rstd(pre[ai * 4 + m]) * sc;
                f32x4 c4 = (f32x4){1.f, 1.f, 1.f, 1.f}, s4 = (f32x4){0.f, 0.f, 0.f, 0.f};
                if (rot) { c4 = *(const f32x4*)(cs + (size_t)row * 16 + 4 * fq); s4 = *(const f32x4*)(cs + (size_t)row * 16 + 8 + 4 * fq); }
#pragma unroll
                for (int bj = 0; bj < 2; ++bj) { const f32x4 v0 = acc[ai][bj][m][0] * rs, v1 = acc[ai][bj][m][1] * rs; f32x4 o0, o1;
                    o0[0] = v0[0] * c4[0] - v0[1] * s4[0]; o0[1] = v0[1] * c4[0] + v0[0] * s4[0]; o0[2] = v0[2] * c4[1] - v0[3] * s4[1]; o0[3] = v0[3] * c4[1] + v0[2] * s4[1];
                    o1[0] = v1[0] * c4[2] - v1[1] * s4[2]; o1[1] = v1[1] * c4[2] + v1[0] * s4[2]; o1[2] = v1[2] * c4[3] - v1[3] * s4[3]; o1[3] = v1[3] * c4[3] + v1[2] * s4[3];
                    store16_wt(O + (size_t)row * ldc + col0 + bj * HALF, pack8(o0, o1)); } }
    }
};

template <class Epi, class Sched, bool ALIGN_EPI = false, bool SP2 = false>
__device__ __forceinline__ void gemm_phase(PG8_LAS unsigned char* lds, const Gemm g, const Sched& S, const Epi& E) {
    int tid_ = threadIdx.x; asm volatile("" : "+v"(tid_));
    const int tid = tid_, wid = __builtin_amdgcn_readfirstlane(tid >> 6), lane = tid & 63, wr = wid >> 2, wc = wid & 3, fr = lane & 15, fq = lane >> 4;
    const int K = g.K, nt = K / BK;
    unsigned voffA[2], voffB[2];
#pragma unroll
    for (int i = 0; i < 2; ++i) { int R, C; stage_rc(tid * 16 + i * 8192, R, C); const int Rb = Epi::PERM ? ((R & ~31) + perm32(R & 31)) : R;
        voffA[i] = (unsigned)(R * K + C) * 2u; voffB[i] = (unsigned)(Rb * K + C) * 2u; }
    const size_t kstep = (size_t)(BK * 2);
    const size_t hstep = (size_t)HALF * K * 2;
    const size_t tstep = 2 * hstep;
    const unsigned ldsw = (unsigned)wid * 1024u;
    const int aoff = lds_byte(wr * 64 + fr, fq * 8), boff = lds_byte(wc * 32 + fr, fq * 8);
#define PG8_SA(b, h) (((b) * 2 + (h)) * HTB)
#define PG8_SB(b, h) ((4 + (b) * 2 + (h)) * HTB)
#define PG8_STAGE(bufoff, gbase, voff) do { _Pragma("unroll") for (int _i = 0; _i < 2; ++_i) \
        __builtin_amdgcn_global_load_lds((const unsigned*)((const char*)(gbase) + (voff)[_i]), (PG8_LAS unsigned*)(lds + (bufoff) + ldsw + _i * 8192), 16, 0, 0); } while (0)
#define PG8_LDA(dst, b, h) do { _Pragma("unroll") for (int m = 0; m < 4; ++m) _Pragma("unroll") for (int k = 0; k < 2; ++k) dst[m][k] = *(const PG8_LAS bf16x8*)(lds + PG8_SA(b, h) + aoff + m * 2048 + k * 1024); } while (0)
#define PG8_LDB(dst, b, h) do { _Pragma("unroll") for (int n = 0; n < 2; ++n) _Pragma("unroll") for (int k = 0; k < 2; ++k) dst[n][k] = *(const PG8_LAS bf16x8*)(lds + PG8_SB(b, h) + boff + n * 2048 + k * 1024); } while (0)
#define PG8_MMA(ai, bj, At, Bt) do { __builtin_amdgcn_s_setprio(1); _Pragma("unroll") for (int m = 0; m < 4; ++m) _Pragma("unroll") for (int n = 0; n < 2; ++n) _Pragma("unroll") for (int k = 0; k < 2; ++k) \
        acc[ai][bj][m][n] = __builtin_amdgcn_mfma_f32_16x16x32_bf16(Bt[n][k], At[m][k], acc[ai][bj][m][n], 0, 0, 0); __builtin_amdgcn_s_setprio(0); } while (0)
#define PG8_WAIT_V(n) asm volatile("s_waitcnt vmcnt(" #n ")" ::: "memory")
#define PG8_WAIT_L(n) asm volatile("s_waitcnt lgkmcnt(" #n ")" ::: "memory")
#define PG8_BAR __builtin_amdgcn_s_barrier()
#define PG8_SCHED __builtin_amdgcn_sched_barrier(0)
    Unit cur, nxt; int ui = 0;
    if (!S.next(0, cur)) return;
    f32x4 acc[2][2][4][2];
#pragma unroll
    for (int a = 0; a < 2; ++a)
#pragma unroll
        for (int b = 0; b < 2; ++b)
#pragma unroll
            for (int m = 0; m < 4; ++m)
#pragma unroll
                for (int n = 0; n < 2; ++n) acc[a][b][m][n] = (f32x4){0.f, 0.f, 0.f, 0.f};
    bf16x8 At[4][2], B0[2][2], B1[2][2]; float pre[8] = {0.f, 0.f, 0.f, 0.f, 0.f, 0.f, 0.f, 0.f};
    const char* cA = (const char*)g.A + (size_t)cur.pm * tstep; const char* cB = (const char*)g.Bt + (size_t)cur.pn * tstep;
    S.a_ready(cur);
    E.prefetch(pre, cur, wr, fr, fq);
    if constexpr (SP2) {
        PG8_STAGE(PG8_SB(0, 0), cB, voffB); PG8_STAGE(PG8_SB(0, 1), cB + hstep, voffB); PG8_STAGE(PG8_SA(0, 0), cA, voffA); PG8_STAGE(PG8_SA(0, 1), cA + hstep, voffA);
        if (wr == 1) PG8_BAR;
        PG8_WAIT_V(2); PG8_BAR;
        PG8_STAGE(PG8_SB(1, 0), cB + kstep, voffB); PG8_STAGE(PG8_SA(1, 0), cA + kstep, voffA); PG8_STAGE(PG8_SB(1, 1), cB + hstep + kstep, voffB);
        PG8_WAIT_V(6); PG8_BAR;
    } else {
        PG8_STAGE(PG8_SB(0, 0), cB, voffB); PG8_STAGE(PG8_SA(0, 0), cA, voffA); PG8_STAGE(PG8_SB(0, 1), cB + hstep, voffB); PG8_STAGE(PG8_SA(0, 1), cA + hstep, voffA);
        if (wr == 1) PG8_BAR;
        PG8_WAIT_V(4); PG8_BAR;
        PG8_STAGE(PG8_SB(1, 0), cB + kstep, voffB); PG8_STAGE(PG8_SA(1, 0), cA + kstep, voffA); PG8_STAGE(PG8_SB(1, 1), cB + hstep + kstep, voffB);
        PG8_WAIT_V(6); PG8_BAR;
    }
    for (;;) {
        const bool has_next = S.next(ui + 1, nxt);
        const char* nA = has_next ? (const char*)g.A + (size_t)nxt.pm * tstep : cA; const char* nB = has_next ? (const char*)g.Bt + (size_t)nxt.pn * tstep : cB;
        for (int t = 0; t < nt; t += 2) {
            const bool last = (t == nt - 2);
            const char* a1 = cA + (size_t)(t + 1) * kstep;
            const char* a2 = last ? nA : cA + (size_t)(t + 2) * kstep; const char* b2 = last ? nB : cB + (size_t)(t + 2) * kstep;
            const char* a3 = a2 + kstep; const char* b3 = b2 + kstep;
            if (last && has_next) S.a_ready(nxt);
            if constexpr (SP2) {
            PG8_LDB(B0, 0, 0); PG8_LDB(B1, 0, 1); PG8_SCHED; PG8_LDA(At, 0, 0); PG8_STAGE(PG8_SA(1, 1), a1 + hstep, voffA);
            PG8_WAIT_V(8); PG8_WAIT_L(0); PG8_BAR; PG8_MMA(0, 0, At, B0); PG8_MMA(0, 1, At, B1); PG8_BAR; PG8_SCHED;
            PG8_LDA(At, 0, 1); PG8_STAGE(PG8_SB(0, 0), b2, voffB); PG8_STAGE(PG8_SB(0, 1), b2 + hstep, voffB); PG8_STAGE(PG8_SA(0, 0), a2, voffA);
            PG8_WAIT_V(8); PG8_WAIT_L(0); PG8_BAR; PG8_MMA(1, 0, At, B0); PG8_MMA(1, 1, At, B1); PG8_BAR; PG8_SCHED;
            PG8_LDB(B0, 1, 0); PG8_LDB(B1, 1, 1); PG8_SCHED; PG8_LDA(At, 1, 0); PG8_STAGE(PG8_SA(0, 1), a2 + hstep, voffA);
            PG8_WAIT_V(8); PG8_WAIT_L(0); PG8_BAR; PG8_MMA(0, 0, At, B0); PG8_MMA(0, 1, At, B1); PG8_BAR; PG8_SCHED;
            PG8_LDA(At, 1, 1); PG8_STAGE(PG8_SB(1, 0), b3, voffB); PG8_STAGE(PG8_SB(1, 1), b3 + hstep, voffB); PG8_STAGE(PG8_SA(1, 0), a3, voffA);
            PG8_WAIT_V(8); PG8_WAIT_L(0); PG8_BAR; PG8_MMA(1, 0, At, B0); PG8_MMA(1, 1, At, B1); PG8_BAR; PG8_SCHED;
            } else {
            PG8_LDB(B0, 0, 0); PG8_SCHED; PG8_LDA(At, 0, 0); PG8_STAGE(PG8_SA(1, 1), a1 + hstep, voffA);
            PG8_WAIT_L(8); PG8_BAR; PG8_WAIT_L(0); PG8_MMA(0, 0, At, B0); PG8_BAR; PG8_SCHED;
            PG8_LDB(B1, 0, 1); PG8_STAGE(PG8_SB(0, 0), b2, voffB);
            PG8_BAR; PG8_WAIT_L(0); PG8_MMA(0, 1, At, B1); PG8_BAR;
            PG8_LDA(At, 0, 1); PG8_STAGE(PG8_SA(0, 0), a2, voffA);
            PG8_BAR; PG8_WAIT_L(0); PG8_MMA(1, 0, At, B0); PG8_BAR; PG8_SCHED;
            PG8_STAGE(PG8_SB(0, 1), b2 + hstep, voffB);
            PG8_WAIT_V(6); PG8_BAR; PG8_MMA(1, 1, At, B1); PG8_BAR;
            PG8_LDB(B0, 1, 0); PG8_SCHED; PG8_LDA(At, 1, 0); PG8_STAGE(PG8_SA(0, 1), a2 + hstep, voffA);
            PG8_WAIT_L(8); PG8_BAR; PG8_WAIT_L(0); PG8_MMA(0, 0, At, B0); PG8_BAR; PG8_SCHED;
            PG8_LDB(B1, 1, 1); PG8_STAGE(PG8_SB(1, 0), b3, voffB);
            PG8_BAR; PG8_WAIT_L(0); PG8_MMA(0, 1, At, B1); PG8_BAR;
            PG8_LDA(At, 1, 1); PG8_STAGE(PG8_SA(1, 0), a3, voffA);
            PG8_BAR; PG8_WAIT_L(0); PG8_MMA(1, 0, At, B0); PG8_BAR; PG8_SCHED;
            PG8_STAGE(PG8_SB(1, 1), b3 + hstep, voffB);
            PG8_WAIT_V(6); PG8_BAR; PG8_MMA(1, 1, At, B1); PG8_BAR;
            }
        }
        if constexpr (ALIGN_EPI) { if (wr == 0) PG8_BAR; }
        if constexpr (!Epi::AFTER_DRAIN) { E(acc, cur, wr, wc, fr, fq, pre); S.done(cur); if (has_next) E.prefetch(pre, nxt, wr, fr, fq); }
        if (!has_next) break;
#pragma unroll
        for (int a = 0; a < 2; ++a)
#pragma unroll
            for (int b = 0; b < 2; ++b)
#pragma unroll
                for (int m = 0; m < 4; ++m)
#pragma unroll
                    for (int n = 0; n < 2; ++n) acc[a][b][m][n] = (f32x4){0.f, 0.f, 0.f, 0.f};
        cur = nxt; cA = nA; cB = nB; ++ui;
        if constexpr (ALIGN_EPI) { if (wr == 1) PG8_BAR; }
    }
    PG8_WAIT_V(0);
    if constexpr (!ALIGN_EPI) { if (wr == 0) PG8_BAR; }
    PG8_BAR;
    if constexpr (Epi::AFTER_DRAIN) { E.fused(acc, cur, wr, wc, fr, fq, lds, wid, lane); S.done(cur); }
#undef PG8_SA
#undef PG8_SB
#undef PG8_STAGE
#undef PG8_LDA
#undef PG8_LDB
#undef PG8_MMA
#undef PG8_WAIT_V
#undef PG8_WAIT_L
#undef PG8_BAR
#undef PG8_SCHED
}
}
#include <hip/hip_bf16.h>
#include <cmath>
namespace attn_body {
using bf16=__hip_bfloat16;
using bf16x8=__attribute__((ext_vector_type(8)))short;
using s16x4=__attribute__((ext_vector_type(4)))short;
using f32x16=__attribute__((ext_vector_type(16)))float;
using u32x4=__attribute__((ext_vector_type(4)))unsigned;
constexpr int BATCH=2,SEQ=8192,D=64;
constexpr int PQ=1024,PK=1536,PV=1536,PO=768;
constexpr int NW=8,QBLK=32,QB=QBLK*NW,KVBLK=64,NQB=SEQ/QB;
constexpr int ATTN_UNIT_ROWS=QB;
__device__ __forceinline__ int crow(int r,int hi){return (r&3)+8*(r>>2)+4*hi;}
#define SBAR() __builtin_amdgcn_sched_barrier(0)
__device__ __forceinline__ void cmask(f32x16&p0,f32x16&p1,int jb,int qrel,int hi){
  const float NEG=-INFINITY; int kb=64*jb+4*hi;
  #pragma unroll
  for(int r=0;r<16;++r){int kv=kb+(r&3)+8*(r>>2); if(kv>qrel)p0[r]=NEG; if(kv+32>qrel)p1[r]=NEG;}
}

constexpr int NSLOT=3, SLOTB=8192;
constexpr int LDS_K=0, LDS_V=NSLOT*SLOTB, LDS_WS=LDS_V+NSLOT*2*SLOTB, LDS_OST=LDS_WS+NW*64*4, LDS_BYTES=LDS_OST+NW*8192;
constexpr float C2=0.125f*1.4426950408889634f;
__device__ __forceinline__ void glds16(const void*gsrc,unsigned lds_dst){unsigned keep;
  asm volatile("s_mov_b32 %0, m0\n\ts_mov_b32 m0, %2\n\ts_nop 0\n\tglobal_load_lds_dwordx4 %1, off\n\ts_mov_b32 m0, %0":"=&s"(keep):"v"(gsrc),"s"(lds_dst):"memory");}
__device__ __forceinline__ float max3f(float a,float b,float c){float r;asm("v_max3_f32 %0, %1, %2, %3":"=v"(r):"v"(a),"v"(b),"v"(c));return r;}
__device__ __forceinline__ float max2f(float a,float b){float r;asm("v_max_f32_e32 %0, %1, %2":"=v"(r):"v"(a),"v"(b));return r;}
__device__ __forceinline__ float fadd_s(float a,float b){float r;asm("v_add_f32_e32 %0, %1, %2":"=v"(r):"v"(a),"v"(b));return r;}
__device__ __forceinline__ float fsub_s(float a,float b){float r;asm("v_sub_f32_e32 %0, %1, %2":"=v"(r):"v"(a),"v"(b));return r;}
typedef float f32x2_t __attribute__((ext_vector_type(2))); typedef __bf16 bf16x2_t __attribute__((ext_vector_type(2)));
__device__ __forceinline__ unsigned cvtpk_s(float lo,float hi){f32x2_t v={lo,hi};bf16x2_t b=__builtin_convertvector(v,bf16x2_t);return __builtin_bit_cast(unsigned,b);}
#define WAIT_BAR(N) asm volatile("s_waitcnt vmcnt(" #N ") lgkmcnt(0)\n\ts_barrier":::"memory")

__device__ __forceinline__ void qkt(f32x16&p0,f32x16&p1,const char*Kslot,const bf16x8*qr,int r32,int hi){
  const char*kb=Kslot+hi*1024+r32*16; const f32x16 z=f32x16{};
  #pragma unroll
  for(int d0=0;d0<4;++d0){
    const bf16x8 b0=*reinterpret_cast<const bf16x8*>(kb+d0*2048);
    const bf16x8 b1=*reinterpret_cast<const bf16x8*>(kb+d0*2048+512);
    if(d0==0){p0=__builtin_amdgcn_mfma_f32_32x32x16_bf16(b0,qr[0],z,0,0,0);p1=__builtin_amdgcn_mfma_f32_32x32x16_bf16(b1,qr[0],z,0,0,0);}
    else{p0=__builtin_amdgcn_mfma_f32_32x32x16_bf16(b0,qr[d0],p0,0,0,0);p1=__builtin_amdgcn_mfma_f32_32x32x16_bf16(b1,qr[d0],p1,0,0,0);}}
}
typedef __attribute__((address_space(3))) const char* lds_cptr;
typedef short v4i16_t __attribute__((ext_vector_type(4)));
__device__ __forceinline__ void kload8(bf16x8*kf,lds_cptr kp){
  kf[0]=*(const __attribute__((address_space(3))) bf16x8*)(kp);      kf[1]=*(const __attribute__((address_space(3))) bf16x8*)(kp+512);
  kf[2]=*(const __attribute__((address_space(3))) bf16x8*)(kp+2048); kf[3]=*(const __attribute__((address_space(3))) bf16x8*)(kp+2560);
  kf[4]=*(const __attribute__((address_space(3))) bf16x8*)(kp+4096); kf[5]=*(const __attribute__((address_space(3))) bf16x8*)(kp+4608);
  kf[6]=*(const __attribute__((address_space(3))) bf16x8*)(kp+6144); kf[7]=*(const __attribute__((address_space(3))) bf16x8*)(kp+6656);
}
__device__ __forceinline__ void kload2(bf16x8*kf,lds_cptr kp,int j){ kf[2*j]=*(const __attribute__((address_space(3))) bf16x8*)(kp+j*2048); kf[2*j+1]=*(const __attribute__((address_space(3))) bf16x8*)(kp+j*2048+512); }
__device__ __forceinline__ s16x4 vtr(lds_cptr p){ return __builtin_bit_cast(s16x4,__builtin_amdgcn_ds_read_tr16_b64_v4i16((__attribute__((address_space(3))) v4i16_t*)p)); }
__device__ __forceinline__ float rowmax(const f32x16&p0,const f32x16&p1){
  float a=max3f(p0[0],p0[1],p1[0]),b=max3f(p0[2],p0[3],p1[1]);a=max3f(a,p1[2],p1[3]);
  #pragma unroll
  for(int r=4;r<16;r+=4){a=max3f(a,p0[r],p0[r+1]);b=max3f(b,p0[r+2],p0[r+3]);a=max3f(a,p1[r],p1[r+1]);b=max3f(b,p1[r+2],p1[r+3]);}
  const float m=max2f(a,b);
  auto rr=__builtin_amdgcn_permlane32_swap(__float_as_uint(m),__float_as_uint(m),false,false);
  return max2f(__uint_as_float(rr[0]),__uint_as_float(rr[1]));
}
__device__ __forceinline__ void pv(f32x16*o,int vb,bf16x8 pa0,bf16x8 pa1,bf16x8 pa2,bf16x8 pa3){
  #pragma unroll
  for(int d0=0;d0<4;++d0){s16x4 lo[4],hi[4];
    #pragma unroll
    for(int ks=0;ks<4;++ks){
      asm volatile("ds_read_b64_tr_b16 %0,%1 offset:%c2":"=&v"(lo[ks]):"v"(vb),"i"(d0*4096+ks*1024):"memory");
      asm volatile("ds_read_b64_tr_b16 %0,%1 offset:%c2":"=&v"(hi[ks]):"v"(vb),"i"(d0*4096+ks*1024+512):"memory");}
    asm volatile("s_waitcnt lgkmcnt(0)":::"memory");SBAR();
    #define PK(k) (bf16x8){lo[k][0],lo[k][1],lo[k][2],lo[k][3],hi[k][0],hi[k][1],hi[k][2],hi[k][3]}
    o[d0]=__builtin_amdgcn_mfma_f32_32x32x16_bf16(pa0,PK(0),o[d0],0,0,0);
    o[d0]=__builtin_amdgcn_mfma_f32_32x32x16_bf16(pa1,PK(1),o[d0],0,0,0);
    o[d0]=__builtin_amdgcn_mfma_f32_32x32x16_bf16(pa2,PK(2),o[d0],0,0,0);
    o[d0]=__builtin_amdgcn_mfma_f32_32x32x16_bf16(pa3,PK(3),o[d0],0,0,0);
    #undef PK
  }
}

#ifndef ATTN_STORE16
#define ATTN_STORE16(p,v) asm volatile("global_store_dwordx4 %0, %1, off sc1\n\ts_nop 1"::"v"(p),"v"(v):"memory")
#endif
template<int THRL,bool FAST> __device__ __forceinline__ bool attn_unit(int qb,const bf16*Qb,const bf16*__restrict__ Kb,const bf16*__restrict__ Vb,bf16*Ob,char*shm){
  int tid_=threadIdx.x; asm volatile("":"+v"(tid_)); const int tid=tid_,lane=tid&63,r32=lane&31,hi=lane>>5; const int wid=__builtin_amdgcn_readfirstlane(tid>>6);
  const int q0=qb*QB;
  const bf16*Qw=Qb+(long)(q0+wid*QBLK)*PQ;
  const bf16*Kh=Kb,*Vh=Vb;
  const unsigned lds0=(unsigned)(uintptr_t)shm;
  float*wsf=(float*)(shm+LDS_WS)+wid*64;
  const bf16*ksrc=Kh+(long)lane*PK+wid*8;
  const bf16*vsrc=Vh+(long)(16*(wid&3)+(lane>>2))*PV+(wid>>2)*32+(lane&3)*8;
  const unsigned kdst=lds0+LDS_K+wid*1024, vdst=lds0+LDS_V+wid*1024;
  #define DMA_K(t,slot) glds16(ksrc+(long)(t)*KVBLK*PK,(unsigned)__builtin_amdgcn_readfirstlane(kdst+(slot)))
  #define DMA_V(t,slot) do{ glds16(vsrc+(long)(t)*KVBLK*PV,(unsigned)__builtin_amdgcn_readfirstlane(vdst+2*(slot))); glds16(vsrc+64+(long)(t)*KVBLK*PV,(unsigned)__builtin_amdgcn_readfirstlane(vdst+2*(slot)+8192)); }while(0)
  const int vb0=(int)(lds0+LDS_V)+((lane>>4)&1)*32+(lane&3)*8+(4*hi+((lane&15)>>2))*64;
  const char*Kbase=shm+LDS_K; bf16x8 kf[8];
  const lds_cptr shm3=(lds_cptr)shm; const lds_cptr kp0=shm3+LDS_K+hi*1024+r32*16; const lds_cptr vp0=shm3+LDS_V+((lane>>4)&1)*32+(lane&3)*8+(4*hi+((lane&15)>>2))*64;
  const int NT=(q0+QB)/KVBLK;
  DMA_K(0,0);DMA_V(0,0);DMA_K(1,SLOTB);
  bf16x8 qr[4];
  #pragma unroll
  for(int d0=0;d0<4;++d0)qr[d0]=*reinterpret_cast<const bf16x8*>(&Qw[(long)r32*PQ+d0*16+hi*8]);
  float mhat=0.f,l_reg=0.f;f32x16 o[4];o[0]=f32x16{};o[1]=f32x16{};o[2]=f32x16{};o[3]=f32x16{};
  const int qrel=wid*QBLK+r32;
  #define CMASK(P0,P1,t) do{int jb_=(t)-(NT-4); if(jb_>=0)cmask(P0,P1,jb_,qrel,hi);}while(0)
  bool resc=false;
  #define START(P0,P1) do{ if constexpr(FAST){ _Pragma("unroll") for(int r=0;r<16;++r){P0[r]=__builtin_amdgcn_exp2f(P0[r]);P1[r]=__builtin_amdgcn_exp2f(P1[r]);} } else { const float rm=rowmax(P0,P1); resc=false; mhat=rm; \
    _Pragma("unroll") for(int r=0;r<16;++r){P0[r]=__builtin_amdgcn_exp2f(fsub_s(P0[r],rm));P1[r]=__builtin_amdgcn_exp2f(fsub_s(P1[r],rm));} } }while(0)
  #define RESC() do{ if(!FAST && resc){ asm volatile("s_waitcnt lgkmcnt(0)":::"memory"); \
      _Pragma("unroll") for(int d_=0;d_<4;++d_) _Pragma("unroll") for(int r=0;r<16;++r)o[d_][r]*=wsf[crow(r,hi)]; } }while(0)
  f32x16 pA0,pA1,pB0,pB1;
  int sl_prev=0,sl_cur=0,sl_next=SLOTB;
  #define ROT() do{sl_prev=sl_cur;sl_cur=sl_next;sl_next=(sl_next==(NSLOT-1)*SLOTB)?0:sl_next+SLOTB;}while(0)
  DMA_K(2,2*SLOTB);
  WAIT_BAR(4);
  qkt(pA0,pA1,Kbase,qr,r32,hi);asm volatile("s_nop 15\n\ts_nop 7":"+v"(pA0),"+v"(pA1));CMASK(pA0,pA1,0);
  START(pA0,pA1);
  WAIT_BAR(0);
  DMA_K(3,0);DMA_V(1,SLOTB);
  ROT();
  kload8(kf,kp0+sl_cur);
  WAIT_BAR(3);
  s16x4 vlo[4],vhi[4]; u32x4 pw0,pw1,pw2,pw3;
  #define PKW(P,B) cvtpk_s(P[B],P[B+1])
  #define PAF(k) __builtin_bit_cast(bf16x8,pw##k)
  #define VFR(i) (bf16x8){vlo[i][0],vlo[i][1],vlo[i][2],vlo[i][3],vhi[i][0],vhi[i][1],vhi[i][2],vhi[i][3]}
  #define PIN(x) asm volatile("":"+v"(x))
  #define MX3(a,b,c) __builtin_fmaxf(__builtin_fmaxf((a),(b)),(c))
  #define GAPA(MF,A0,A1,A2,A3,W0,W1,PW) do{ MF; sacc+=A0; sacc+=A1; sacc+=A2; sacc+=A3; PIN(sacc); W0; W1; PIN(PW); SBAR(); }while(0)
  #define EX(v) __builtin_amdgcn_exp2f(v)
  #define VOFF(m) (((((m)&1)+2*((m)>>3))*4096)+((((m)>>1)&3)*1024))
  #define VRD(m) do{ vlo[(m)&3]=vtr(vp_+VOFF(m)); vhi[(m)&3]=vtr(vp_+VOFF(m)+512); }while(0)
  #define GAPB(MF,RD,X,B) do{ MF; RD; if constexpr(FAST){ X[B]=EX(X[B]); X[B+1]=EX(X[B+1]); } else { X[B]=EX(X[B]-mhat); X[B+1]=EX(X[B+1]-mhat); } PIN(X); SBAR(); }while(0)
  #define NORD do{}while(0)
  #define KRD(G,j) do{ if(G){ kload2(kf,kp0+sl_next,j); SBAR(); } }while(0)
  #define PVM(db,k,f) o[db]=__builtin_amdgcn_mfma_f32_32x32x16_bf16(PAF(k),VFR(f),o[db],0,0,0)
  #define STEP(C0,C1,P0,P1,t,GK,GV,GL) do{ SBAR(); \
    const lds_cptr vp_=vp0+2*sl_prev; const f32x16 z_=f32x16{}; \
    float sacc=(P0[0]+P0[1]); \
    GAPA(C0=__builtin_amdgcn_mfma_f32_32x32x16_bf16(kf[0],qr[0],z_,0,0,0), P0[2],P0[3],P0[4],P0[5],     pw0[0]=PKW(P0,0), pw0[1]=PKW(P0,2), pw0); \
    GAPA(C1=__builtin_amdgcn_mfma_f32_32x32x16_bf16(kf[1],qr[0],z_,0,0,0), P0[6],P0[7],P0[8],P0[9],     pw0[2]=PKW(P0,4), pw0[3]=PKW(P0,6), pw0); \
    GAPA(C0=__builtin_amdgcn_mfma_f32_32x32x16_bf16(kf[2],qr[1],C0,0,0,0),   P0[10],P0[11],P0[12],P0[13], pw1[0]=PKW(P0,8), pw1[1]=PKW(P0,10), pw1); \
    GAPA(C1=__builtin_amdgcn_mfma_f32_32x32x16_bf16(kf[3],qr[1],C1,0,0,0),   P0[14],P0[15],P1[0],P1[1],   pw1[2]=PKW(P0,12),pw1[3]=PKW(P0,14), pw1); \
    VRD(0); SBAR(); GAPA(C0=__builtin_amdgcn_mfma_f32_32x32x16_bf16(kf[4],qr[2],C0,0,0,0),   P1[2],P1[3],P1[4],P1[5],     pw2[0]=PKW(P1,0), pw2[1]=PKW(P1,2), pw2); \
    VRD(1); SBAR(); GAPA(C1=__builtin_amdgcn_mfma_f32_32x32x16_bf16(kf[5],qr[2],C1,0,0,0),   P1[6],P1[7],P1[8],P1[9],     pw2[2]=PKW(P1,4), pw2[3]=PKW(P1,6), pw2); \
    VRD(2); SBAR(); GAPA(C0=__builtin_amdgcn_mfma_f32_32x32x16_bf16(kf[6],qr[3],C0,0,0,0),   P1[10],P1[11],P1[12],P1[13], pw3[0]=PKW(P1,8), pw3[1]=PKW(P1,10), pw3); \
    VRD(3); SBAR(); GAPA(C1=__builtin_amdgcn_mfma_f32_32x32x16_bf16(kf[7],qr[3],C1,0,0,0),   P1[14],P1[15],0.f,0.f,       pw3[2]=PKW(P1,12),pw3[3]=PKW(P1,14), pw3); \
    l_reg+=sacc; \
    if(GK){DMA_K((t)+3,sl_cur);} if(GV){DMA_V((t)+1,sl_next);} \
    CMASK(C0,C1,t); \
        if constexpr(!FAST) { float a=MX3(C0[0],C0[1],C1[0]),b=MX3(C0[2],C0[3],C1[1]); a=MX3(a,C1[2],C1[3]); \
      _Pragma("unroll") for(int r=4;r<16;r+=4){a=MX3(a,C0[r],C0[r+1]);b=MX3(b,C0[r+2],C0[r+3]);a=MX3(a,C1[r],C1[r+1]);b=MX3(b,C1[r+2],C1[r+3]);} \
      float rm=__builtin_fmaxf(a,b); { auto rr=__builtin_amdgcn_permlane32_swap(__float_as_uint(rm),__float_as_uint(rm),false,false); rm=__builtin_fmaxf(__uint_as_float(rr[0]),__uint_as_float(rr[1])); } \
      resc=false; rm-=mhat; \
      if(__builtin_expect(__any(rm>(float)THRL),0)){ const float dl=__builtin_fmaxf(rm,0.f); mhat+=dl; \
        const float f=__builtin_amdgcn_exp2f(-dl); l_reg*=f; if(hi==0)wsf[r32]=f; resc=true; } } \
    SBAR(); \
    GAPB(PVM(0,0,0), VRD(4), C0,0); \
    GAPB(PVM(1,0,1), VRD(5), C0,2); \
    GAPB(PVM(0,1,2), VRD(6), C0,4); \
    GAPB(PVM(1,1,3), VRD(7), C0,6); \
    KRD(GL,0); GAPB(PVM(0,2,0), VRD(8), C0,8); \
    GAPB(PVM(1,2,1), VRD(9), C0,10); \
    KRD(GL,1); GAPB(PVM(0,3,2), VRD(10), C0,12); \
    GAPB(PVM(1,3,3), VRD(11), C0,14); \
    KRD(GL,2); GAPB(PVM(2,0,0), VRD(12), C1,0); \
    GAPB(PVM(3,0,1), VRD(13), C1,2); \
    KRD(GL,3); GAPB(PVM(2,1,2), VRD(14), C1,4); \
    GAPB(PVM(3,1,3), VRD(15), C1,6); \
    GAPB(PVM(2,2,0), NORD, C1,8); \
    GAPB(PVM(3,2,1), NORD, C1,10); \
    GAPB(PVM(2,3,2), NORD, C1,12); \
    GAPB(PVM(3,3,3), NORD, C1,14); \
    }while(0)
  int t=1;
  #undef CMASK
  #define CMASK(P0,P1,t) do{}while(0)
  for(;t+5<NT;t+=2){
    STEP(pB0,pB1,pA0,pA1,t,true,true,true);     WAIT_BAR(3); RESC(); ROT();
    STEP(pA0,pA1,pB0,pB1,t+1,true,true,true);   WAIT_BAR(3); RESC(); ROT();
  }
  #undef CMASK
  #define CMASK(P0,P1,t) do{int jb_=(t)-(NT-4); if(jb_>=0)cmask(P0,P1,jb_,qrel,hi);}while(0)
  #define ENDW(tt) do{ if((tt)+3<NT){WAIT_BAR(3);} else if((tt)+2<NT){WAIT_BAR(2);} else {WAIT_BAR(0);} }while(0)
  for(;t+1<NT;t+=2){
    STEP(pB0,pB1,pA0,pA1,t,(t+3<NT),(t+1<NT),(t+1<NT));       ENDW(t);   RESC(); ROT();
    STEP(pA0,pA1,pB0,pB1,t+1,(t+4<NT),(t+2<NT),(t+2<NT));     ENDW(t+1); RESC(); ROT();
  }
  STEP(pB0,pB1,pA0,pA1,NT-1,false,false,false); RESC();
  { float sacc=pB0[0]+pB0[1]; _Pragma("unroll") for(int r=2;r<16;++r)sacc+=pB0[r]; _Pragma("unroll") for(int r=0;r<16;++r)sacc+=pB1[r]; l_reg+=sacc;
    pw0=(u32x4){PKW(pB0,0),PKW(pB0,2),PKW(pB0,4),PKW(pB0,6)};pw1=(u32x4){PKW(pB0,8),PKW(pB0,10),PKW(pB0,12),PKW(pB0,14)};pw2=(u32x4){PKW(pB1,0),PKW(pB1,2),PKW(pB1,4),PKW(pB1,6)};pw3=(u32x4){PKW(pB1,8),PKW(pB1,10),PKW(pB1,12),PKW(pB1,14)};
    SBAR(); pv(o,vb0+2*sl_cur,PAF(0),PAF(1),PAF(2),PAF(3)); }
  #undef PKW
  #undef PAF
  #undef VFR
  #undef PIN
  #undef MX3
  #undef GAPA
  #undef GAPB
  #undef NORD
  #undef PVM
  #undef VOFF
  #undef EX
  #undef VRD
  #undef KRD
  #undef STEP
  #undef ENDW
  {auto rr=__builtin_amdgcn_permlane32_swap(__float_as_uint(l_reg),__float_as_uint(l_reg),false,false);l_reg=__uint_as_float(rr[0])+__uint_as_float(rr[1]);}
  if(hi==0)wsf[32+r32]=l_reg;asm volatile("s_waitcnt lgkmcnt(0)":::"memory");
  float rli[16];
  #pragma unroll
  for(int r=0;r<16;++r)rli[r]=__builtin_amdgcn_rcpf(wsf[32+crow(r,hi)]);
  bf16*Ow=Ob+(long)(q0+wid*QBLK)*PO;
  { bf16*stg=(bf16*)(shm+LDS_OST)+wid*4096;
    #pragma unroll
    for(int r=0;r<16;++r){const int orow=crow(r,hi);
      #pragma unroll
      for(int d0=0;d0<4;++d0)stg[orow*128+d0*32+r32]=__float2bfloat16(o[d0][r]*rli[r]);}
    asm volatile("s_waitcnt lgkmcnt(0)":::"memory");
    #pragma unroll
    for(int i=0;i<8;++i){const int row=i*4+(lane>>4),ch=lane&15; const u32x4 v=*(const u32x4*)(stg+row*128+ch*8); ATTN_STORE16(Ow+(long)row*PO+ch*8,v);} }
  bool bad=false;
  if constexpr(FAST){ int* flg=(int*)(shm+LDS_WS); asm volatile("s_waitcnt lgkmcnt(0)\n\ts_barrier":::"memory");
    if(tid==0)flg[0]=0; asm volatile("s_waitcnt lgkmcnt(0)\n\ts_barrier":::"memory");
    if(__any(!(l_reg>0x1p-60f&&l_reg<0x1p60f))&&lane==0)flg[0]=1; asm volatile("s_waitcnt lgkmcnt(0)\n\ts_barrier":::"memory");
    bad=flg[0]!=0; }
  asm volatile("s_waitcnt lgkmcnt(0)\n\ts_barrier":::"memory");
  #undef DMA_K
  #undef DMA_V
  #undef CMASK
  #undef START
  #undef RESC
  #undef ROT
  return bad;
}
template<bool LATE> __device__ __forceinline__ bool attn_unit_fast(int qb,const bf16*Qb,const bf16*__restrict__ Kb,const bf16*__restrict__ Vb,bf16*Ob,char*shm){
  int tid_=threadIdx.x; asm volatile("":"+v"(tid_)); const int tid=tid_,lane=tid&63,r32=lane&31,hi=lane>>5; const int wid=__builtin_amdgcn_readfirstlane(tid>>6);
  constexpr int FK=0, FV=4*SLOTB, FWS=FV+4*2*SLOTB, FOST=0;
  const int q0=qb*QB;
  const bf16*Qw=Qb+(long)(q0+wid*QBLK)*PQ;
  const unsigned lds0=(unsigned)(uintptr_t)shm;
  float*wsf=(float*)(shm+FWS)+wid*64;
  const bf16*ksrc=Kb+(long)lane*PK+wid*8;
  const bf16*vsrc=Vb+(long)(16*(wid&3)+(lane>>2))*PV+(wid>>2)*32+(lane&3)*8;
  const unsigned kdst=lds0+FK+wid*1024, vdst=lds0+FV+wid*1024;
  #define KSL(t) (((t)&3)*SLOTB)
  #define RFL(x) ((unsigned)__builtin_amdgcn_readfirstlane(x))
  #define DMA_K(t) glds16(ksrc+(long)(t)*KVBLK*PK,RFL(kdst+KSL(t)))
  #define DMA_V(t) do{ glds16(vsrc+(long)(t)*KVBLK*PV,RFL(vdst+2*KSL(t))); glds16(vsrc+64+(long)(t)*KVBLK*PV,RFL(vdst+2*KSL(t)+8192)); }while(0)
  const int vb0=(int)(lds0+FV)+((lane>>4)&1)*32+(lane&3)*8+(4*hi+((lane&15)>>2))*64;
  bf16x8 kf[8];
  const lds_cptr shm3=(lds_cptr)shm; const lds_cptr kp0=shm3+FK+hi*1024+r32*16; const lds_cptr vp0=shm3+FV+((lane>>4)&1)*32+(lane&3)*8+(4*hi+((lane&15)>>2))*64;
  const int NT=(q0+QB)/KVBLK;
  DMA_K(0);DMA_V(0);DMA_K(1);
  bf16x8 qr[4];
  #pragma unroll
  for(int d0=0;d0<4;++d0)qr[d0]=*reinterpret_cast<const bf16x8*>(&Qw[(long)r32*PQ+d0*16+hi*8]);
  float l_reg=0.f;f32x16 o[4];o[0]=f32x16{};o[1]=f32x16{};o[2]=f32x16{};o[3]=f32x16{};
  const int qrel=wid*QBLK+r32;
  #define CMASK(P0,P1,t) do{int jb_=(t)-(NT-4); if(jb_>=0)cmask(P0,P1,jb_,qrel,hi);}while(0)
  f32x16 pA0,pA1,pB0,pB1;
  DMA_K(2);
  WAIT_BAR(4);
  qkt(pA0,pA1,shm+FK,qr,r32,hi);asm volatile("s_nop 15\n\ts_nop 7":"+v"(pA0),"+v"(pA1));CMASK(pA0,pA1,0);
  _Pragma("unroll") for(int r=0;r<16;++r){pA0[r]=__builtin_amdgcn_exp2f(pA0[r]);pA1[r]=__builtin_amdgcn_exp2f(pA1[r]);}
  WAIT_BAR(0);
  DMA_K(3);DMA_V(1);
  kload8(kf,kp0+KSL(1));
  WAIT_BAR(3);
  s16x4 vlo[4],vhi[4]; u32x4 pw0,pw1,pw2,pw3;
  #define PKW(P,B) cvtpk_s(P[B],P[B+1])
  #define PAF(k) __builtin_bit_cast(bf16x8,pw##k)
  #define VFR(i) (bf16x8){vlo[i][0],vlo[i][1],vlo[i][2],vlo[i][3],vhi[i][0],vhi[i][1],vhi[i][2],vhi[i][3]}
  #define PIN(x) asm volatile("":"+v"(x))
  #define GAPA(MF,A0,A1,A2,A3,W0,W1,PW) do{ MF; sacc+=A0; sacc+=A1; sacc+=A2; sacc+=A3; PIN(sacc); W0; W1; PIN(PW); SBAR(); }while(0)
  #define EX(v) __builtin_amdgcn_exp2f(v)
  #define VOFF(m) (((((m)&1)+2*((m)>>3))*4096)+((((m)>>1)&3)*1024))
  #define VRD(m) do{ vlo[(m)&3]=vtr(vp_+VOFF(m)); vhi[(m)&3]=vtr(vp_+VOFF(m)+512); }while(0)
  #define GAPB(MF,RD,X,B) do{ MF; RD; X[B]=EX(X[B]); X[B+1]=EX(X[B+1]); PIN(X); SBAR(); }while(0)
  #define NORD do{}while(0)
  #define KRD(G,j,t) do{ if(G){ kload2(kf,kp0+KSL((t)+1),j); SBAR(); } }while(0)
  #define PVM(db,k,f) o[db]=__builtin_amdgcn_mfma_f32_32x32x16_bf16(PAF(k),VFR(f),o[db],0,0,0)
  #define PHA(C0,C1,P0,P1,t) do{ SBAR(); \
    const lds_cptr vp_=vp0+2*KSL((t)-1); const f32x16 z_=f32x16{}; \
    float sacc=(P0[0]+P0[1]); \
    GAPA(C0=__builtin_amdgcn_mfma_f32_32x32x16_bf16(kf[0],qr[0],z_,0,0,0), P0[2],P0[3],P0[4],P0[5],     pw0[0]=PKW(P0,0), pw0[1]=PKW(P0,2), pw0); \
    GAPA(C1=__builtin_amdgcn_mfma_f32_32x32x16_bf16(kf[1],qr[0],z_,0,0,0), P0[6],P0[7],P0[8],P0[9],     pw0[2]=PKW(P0,4), pw0[3]=PKW(P0,6), pw0); \
    GAPA(C0=__builtin_amdgcn_mfma_f32_32x32x16_bf16(kf[2],qr[1],C0,0,0,0),   P0[10],P0[11],P0[12],P0[13], pw1[0]=PKW(P0,8), pw1[1]=PKW(P0,10), pw1); \
    GAPA(C1=__builtin_amdgcn_mfma_f32_32x32x16_bf16(kf[3],qr[1],C1,0,0,0),   P0[14],P0[15],P1[0],P1[1],   pw1[2]=PKW(P0,12),pw1[3]=PKW(P0,14), pw1); \
    VRD(0); SBAR(); GAPA(C0=__builtin_amdgcn_mfma_f32_32x32x16_bf16(kf[4],qr[2],C0,0,0,0),   P1[2],P1[3],P1[4],P1[5],     pw2[0]=PKW(P1,0), pw2[1]=PKW(P1,2), pw2); \
    VRD(1); SBAR(); GAPA(C1=__builtin_amdgcn_mfma_f32_32x32x16_bf16(kf[5],qr[2],C1,0,0,0),   P1[6],P1[7],P1[8],P1[9],     pw2[2]=PKW(P1,4), pw2[3]=PKW(P1,6), pw2); \
    VRD(2); SBAR(); GAPA(C0=__builtin_amdgcn_mfma_f32_32x32x16_bf16(kf[6],qr[3],C0,0,0,0),   P1[10],P1[11],P1[12],P1[13], pw3[0]=PKW(P1,8), pw3[1]=PKW(P1,10), pw3); \
    VRD(3); SBAR(); GAPA(C1=__builtin_amdgcn_mfma_f32_32x32x16_bf16(kf[7],qr[3],C1,0,0,0),   P1[14],P1[15],0.f,0.f,       pw3[2]=PKW(P1,12),pw3[3]=PKW(P1,14), pw3); \
    l_reg+=sacc; SBAR(); }while(0)
  #define DMAI(t,GK,GV) do{ if(GK){DMA_K((t)+3);} if(GV){DMA_V((t)+1);} }while(0)
  #define PHB(C0,C1,t,GL) do{ SBAR(); CMASKB(C0,C1,t); \
    const lds_cptr vp_=vp0+2*KSL((t)-1); \
    GAPB(PVM(0,0,0), VRD(4), C0,0); \
    GAPB(PVM(1,0,1), VRD(5), C0,2); \
    GAPB(PVM(0,1,2), VRD(6), C0,4); \
    GAPB(PVM(1,1,3), VRD(7), C0,6); \
    KRD(GL,0,t); GAPB(PVM(0,2,0), VRD(8), C0,8); \
    GAPB(PVM(1,2,1), VRD(9), C0,10); \
    KRD(GL,1,t); GAPB(PVM(0,3,2), VRD(10), C0,12); \
    GAPB(PVM(1,3,3), VRD(11), C0,14); \
    KRD(GL,2,t); GAPB(PVM(2,0,0), VRD(12), C1,0); \
    GAPB(PVM(3,0,1), VRD(13), C1,2); \
    KRD(GL,3,t); GAPB(PVM(2,1,2), VRD(14), C1,4); \
    GAPB(PVM(3,1,3), VRD(15), C1,6); \
    GAPB(PVM(2,2,0), NORD, C1,8); \
    GAPB(PVM(3,2,1), NORD, C1,10); \
    GAPB(PVM(2,3,2), NORD, C1,12); \
    GAPB(PVM(3,3,3), NORD, C1,14); \
    }while(0)
  #define ENDW(tt) do{ if((tt)+3<NT){WAIT_BAR(3);} else if((tt)+2<NT){WAIT_BAR(2);} else {WAIT_BAR(0);} }while(0)
  if constexpr(!LATE){
    int t=1;
    #define CMASKB(P0,P1,t) do{}while(0)
    for(;t+5<NT;t+=2){
      PHA(pB0,pB1,pA0,pA1,t);   DMAI(t,true,true);   PHB(pB0,pB1,t,true);   WAIT_BAR(3);
      PHA(pA0,pA1,pB0,pB1,t+1); DMAI(t+1,true,true); PHB(pA0,pA1,t+1,true); WAIT_BAR(3);
    }
    #undef CMASKB
    #define CMASKB(P0,P1,t) CMASK(P0,P1,t)
    for(;t+1<NT;t+=2){
      PHA(pB0,pB1,pA0,pA1,t);   DMAI(t,(t+3<NT),(t+1<NT));   PHB(pB0,pB1,t,(t+1<NT));   ENDW(t);
      PHA(pA0,pA1,pB0,pB1,t+1); DMAI(t+1,(t+4<NT),(t+2<NT)); PHB(pA0,pA1,t+1,(t+2<NT)); ENDW(t+1);
    }
    PHA(pB0,pB1,pA0,pA1,NT-1); PHB(pB0,pB1,NT-1,false);
    #undef CMASKB
  } else {
    DMAI(1,(4<NT),(2<NT)); PHA(pB0,pB1,pA0,pA1,1); ENDW(1);
    int t=2;
    #define CMASKB(P0,P1,t) do{}while(0)
    for(;t+4<NT;t+=2){
      PHB(pB0,pB1,t-1,true); DMAI(t,true,true);   PHA(pA0,pA1,pB0,pB1,t);   WAIT_BAR(3);
      PHB(pA0,pA1,t,true);   DMAI(t+1,true,true); PHA(pB0,pB1,pA0,pA1,t+1); WAIT_BAR(3);
    }
    #undef CMASKB
    #define CMASKB(P0,P1,t) CMASK(P0,P1,t)
    for(;t+1<NT;t+=2){
      PHB(pB0,pB1,t-1,true);     DMAI(t,(t+3<NT),(t+1<NT));   PHA(pA0,pA1,pB0,pB1,t);   ENDW(t);
      PHB(pA0,pA1,t,(t+1<NT));   DMAI(t+1,(t+4<NT),(t+2<NT)); PHA(pB0,pB1,pA0,pA1,t+1); if(t+2<NT){ENDW(t+1);}
    }
    PHB(pB0,pB1,NT-1,false);
    #undef CMASKB
  }
  { float sacc=pB0[0]+pB0[1]; _Pragma("unroll") for(int r=2;r<16;++r)sacc+=pB0[r]; _Pragma("unroll") for(int r=0;r<16;++r)sacc+=pB1[r]; l_reg+=sacc;
    pw0=(u32x4){PKW(pB0,0),PKW(pB0,2),PKW(pB0,4),PKW(pB0,6)};pw1=(u32x4){PKW(pB0,8),PKW(pB0,10),PKW(pB0,12),PKW(pB0,14)};pw2=(u32x4){PKW(pB1,0),PKW(pB1,2),PKW(pB1,4),PKW(pB1,6)};pw3=(u32x4){PKW(pB1,8),PKW(pB1,10),PKW(pB1,12),PKW(pB1,14)};
    SBAR(); pv(o,vb0+2*KSL(NT-1),PAF(0),PAF(1),PAF(2),PAF(3)); }
  #undef PKW
  #undef PAF
  #undef VFR
  #undef PIN
  #undef GAPA
  #undef GAPB
  #undef NORD
  #undef PVM
  #undef VOFF
  #undef EX
  #undef VRD
  #undef KRD
  #undef PHA
  #undef PHB
  #undef DMAI
  #undef ENDW
  asm volatile("s_waitcnt lgkmcnt(0)\n\ts_barrier":::"memory");
  {auto rr=__builtin_amdgcn_permlane32_swap(__float_as_uint(l_reg),__float_as_uint(l_reg),false,false);l_reg=__uint_as_float(rr[0])+__uint_as_float(rr[1]);}
  if(hi==0)wsf[32+r32]=l_reg;asm volatile("s_waitcnt lgkmcnt(0)":::"memory");
  float rli[16];
  #pragma unroll
  for(int r=0;r<16;++r)rli[r]=__builtin_amdgcn_rcpf(wsf[32+crow(r,hi)]);
  bf16*Ow=Ob+(long)(q0+wid*QBLK)*PO;
  { bf16*stg=(bf16*)(shm+FOST)+wid*4096;
    #pragma unroll
    for(int r=0;r<16;++r){const int orow=crow(r,hi);
      #pragma unroll
      for(int d0=0;d0<4;++d0)stg[orow*128+d0*32+r32]=__float2bfloat16(o[d0][r]*rli[r]);}
    asm volatile("s_waitcnt lgkmcnt(0)":::"memory");
    #pragma unroll
    for(int i=0;i<8;++i){const int row=i*4+(lane>>4),ch=lane&15; const u32x4 v=*(const u32x4*)(stg+row*128+ch*8); ATTN_STORE16(Ow+(long)row*PO+ch*8,v);} }
  bool bad=false;
  { int* flg=(int*)(shm+FWS); asm volatile("s_waitcnt lgkmcnt(0)\n\ts_barrier":::"memory");
    if(tid==0)flg[0]=0; asm volatile("s_waitcnt lgkmcnt(0)\n\ts_barrier":::"memory");
    if(__any(!(l_reg>0x1p-60f&&l_reg<0x1p60f))&&lane==0)flg[0]=1; asm volatile("s_waitcnt lgkmcnt(0)\n\ts_barrier":::"memory");
    bad=flg[0]!=0; }
  asm volatile("s_waitcnt lgkmcnt(0)\n\ts_barrier":::"memory");
  #undef DMA_K
  #undef DMA_V
  #undef KSL
  #undef RFL
  #undef CMASK
  return bad;
}
constexpr int ATTN_LDS_BYTES=LDS_BYTES;
template<int THRL=8> __device__ __forceinline__ void attn_phase(char*lds,const bf16*Q,const bf16*K,const bf16*V,bf16*O,int vcu,int G){
  const int nun=(G==256)?3:(24*32+G-1)/G;
  for(int i=0;i<nun;++i){
    int vh,qb;
    if(G==256){ const int x=vcu>>5,j=vcu&31; vh=3*x+i; qb=(i==0)?j:(i==1)?((j<16)?j+16:j-16):((j<16)?31-2*j:62-2*j); }
    else { const int u=vcu+i*G; if(u>=24*32)break; vh=u>>5; qb=u&31; }
    const int b=vh/12,r=vh%12,h=r>>1,c=r&1;
    const long rb=(long)b*SEQ;
    const bool late=__builtin_amdgcn_readfirstlane((int)(threadIdx.x>>8))!=0;
    const bf16*Qp=Q+rb*PQ+h*128+c*64,*Kp=K+rb*PK+h*128+c*64,*Vp=V+rb*PV+h*128; bf16*Op=O+((long)c*BATCH*SEQ+rb)*PO+h*128;
    bool bad; if(late) bad=attn_unit_fast<true>(qb,Qp,Kp,Vp,Op,lds); else bad=attn_unit_fast<false>(qb,Qp,Kp,Vp,Op,lds);
    if(bad)
      attn_unit<THRL,false>(qb,Q+rb*PQ+h*128+c*64,K+rb*PK+h*128+c*64,V+rb*PV+h*128,O+((long)c*BATCH*SEQ+rb)*PO+h*128,lds);
  }
}
#undef SBAR
#undef WAIT_BAR
}
#include <hip/hip_cooperative_groups.h>
namespace cg = cooperative_groups;
#define GAS __attribute__((address_space(1)))
#define LAS __attribute__((address_space(3)))
typedef unsigned short bf16;
typedef unsigned v4u __attribute__((ext_vector_type(4)));
typedef unsigned v2u __attribute__((ext_vector_type(2)));
typedef float f32x4 __attribute__((ext_vector_type(4)));
typedef float f32x16 __attribute__((ext_vector_type(16)));
typedef short bf16x8 __attribute__((ext_vector_type(8)));
typedef short s16x4 __attribute__((ext_vector_type(4)));
#define LDS_WAIT() asm volatile("s_waitcnt lgkmcnt(0)" ::: "memory")

constexpr int NWAVES = 8, NTHR = 512;
constexpr int BATCH = 2, SEQ = 8192, T = BATCH * SEQ, D = 1024, FF = 2816, MIX = 768, NMEM = 256;
constexpr int PROJW = 3 * MIX + 256;
constexpr float EPS = 1e-6f;
constexpr float LAM_INIT = 0.35550906759096934f;
constexpr float C2 = 0.125f * 1.4426950408889634f;
constexpr size_t MiB = 1u << 20;
constexpr size_t WS_CTL = 0, WS_SSQ = 1 * MiB, WS_CS = 2 * MiB, WS_MEMB = 3 * MiB, WS_MEMKV = 4 * MiB, WS_SSQM = 5 * MiB, WS_W = 6 * MiB, WS_HB = 88 * MiB, WS_ACT = 120 * MiB, WS_KV = 208 * MiB, WS_END = 256 * MiB;
constexpr size_t WS_OB = 152 * MiB;
constexpr size_t W1_SZ = (size_t)2 * FF * D, W2_SZ = (size_t)D * FF;
constexpr size_t WO_W1_0 = 0, WO_W1_1 = W1_SZ, WO_KV = 2 * W1_SZ, WO_W1_2 = WO_KV + (size_t)1536 * D, WO_W1_3 = WO_W1_2 + W1_SZ, WO_W2 = WO_W1_3 + W1_SZ,
                 WO_AIN = WO_W2 + 4 * W2_SZ, WO_AOUT = WO_AIN + (size_t)PROJW * D, WO_Q = WO_AOUT + (size_t)D * D, WO_BOUT = WO_Q + (size_t)D * D, WO_MKV = WO_BOUT + (size_t)D * D, WO_END = WO_MKV + (size_t)2 * 512 * D;
static_assert(WO_END * 2 == 82 * MiB, "weights fill [6, 88) MiB");
constexpr int LDS_BYTES = 147456;

enum { K_PREP = 0, K_SWIGLU = 1, K_RES = 2, K_SCALE = 3, K_ROPE = 4, K_MIXA = 5, K_ATTN = 6, K_COMB = 7, K_FINAL = 8 };
struct Step { int kind, sync_after, M, N, K, ldc; float scale; int pad; int coff, tskip; const void* A; const void* Bt; void* p0; void* p1; void* p2; void* p3; };
constexpr int MAX_STEPS = 40;
struct Args { Step steps[MAX_STEPS]; const void* in[22]; float* out; unsigned char* ws; int lo, hi; };

__device__ __forceinline__ float bf_lo(unsigned w) { return __builtin_bit_cast(float, w << 16); }
__device__ __forceinline__ float bf_hi(unsigned w) { return __builtin_bit_cast(float, w & 0xffff0000u); }
__device__ __forceinline__ unsigned pk2(float lo, float hi) { return pg8::cvt_pk_bf16(lo, hi); }
__device__ __forceinline__ void st16_wt(void* p, const v4u v) { asm volatile("global_store_dwordx4 %0, %1, off sc1\n\ts_nop 1" :: "v"(p), "v"(v) : "memory"); }
__device__ __forceinline__ float wave_sum(float v) {
#pragma unroll
    for (int o = 1; o < 64; o <<= 1) v += __shfl_xor(v, o);
    return v;
}

struct WJob { const float* W; const float* gain; bf16* Wt; int K, N, mode; };
__device__ __forceinline__ void transpose_item(const WJob& J, LAS float* scr, int item, int lane) {
    const int nblk = J.N / 32, kb = item / nblk, nb = item % nblk, k0 = 64 * kb, n0d = 32 * nb;
    int n0s = n0d; bool perm = false;
    if (J.mode == 1) { const int pn = n0d >> 8, j = n0d & 255; n0s = (j < 128) ? (128 * pn + j) : (FF + 128 * pn + (j - 128)); }
    if (J.mode == 2) perm = (n0d < MIX) && ((n0d & 63) == 0);
    const int c = lane & 7;
    f32x4 g0 = (f32x4){1.f, 1.f, 1.f, 1.f}, g1 = g0;
    if (J.gain) { g0 = *(const f32x4*)(J.gain + k0 + 8 * c); g1 = *(const f32x4*)(J.gain + k0 + 8 * c + 4); }
    const float* src = J.W + (size_t)(k0 + (lane >> 5)) * J.N + n0s + (lane & 31);
    float v[32];
#pragma unroll
    for (int i = 0; i < 32; ++i) v[i] = __builtin_nontemporal_load(src + (size_t)(2 * i) * J.N);
#pragma unroll
    for (int i = 0; i < 32; ++i) scr[(2 * i + (lane >> 5)) * 33 + (lane & 31)] = v[i];
    LDS_WAIT(); asm volatile("" ::: "memory");
#pragma unroll
    for (int j = 0; j < 4; ++j) { const int n = (lane >> 3) + 8 * j; const int ns = (perm && n < 16) ? ((n & 1) ? 8 + (n >> 1) : (n >> 1)) : n;
        const LAS float* s = scr + (8 * c) * 33 + ns;
        v4u o; o.x = pk2(s[0 * 33] * g0[0], s[1 * 33] * g0[1]); o.y = pk2(s[2 * 33] * g0[2], s[3 * 33] * g0[3]); o.z = pk2(s[4 * 33] * g1[0], s[5 * 33] * g1[1]); o.w = pk2(s[6 * 33] * g1[2], s[7 * 33] * g1[3]);
        st16_wt(J.Wt + (size_t)(n0d + n) * J.K + k0 + 8 * c, o); }
    LDS_WAIT(); asm volatile("" ::: "memory");
}
__device__ __forceinline__ void row_to_bf16(const float* xrow, bf16* orow, float* ssqrow, int lane) {
    const f32x4* xr = (const f32x4*)xrow + 2 * lane; f32x4 v[4]; float s = 0.f;
#pragma unroll
    for (int j = 0; j < 4; ++j) { v[j] = __builtin_nontemporal_load(xr + (j & 1) + 128 * (j >> 1)); s += (v[j][0] * v[j][0] + v[j][1] * v[j][1]) + (v[j][2] * v[j][2] + v[j][3] * v[j][3]); }
    s = wave_sum(s);
#pragma unroll
    for (int h = 0; h < 2; ++h) { v4u w; w.x = pk2(v[2 * h][0], v[2 * h][1]); w.y = pk2(v[2 * h][2], v[2 * h][3]); w.z = pk2(v[2 * h + 1][0], v[2 * h + 1][1]); w.w = pk2(v[2 * h + 1][2], v[2 * h + 1][3]);
        st16_wt(orow + 8 * lane + 512 * h, w); }
    if (lane < 4) ssqrow[lane] = (lane == 0) ? s : 0.f;
}
typedef const __attribute__((address_space(4))) Args* ArgsP;
constexpr int I_W1 = (D / 64) * (2 * FF / 32), I_W2 = (FF / 64) * (D / 32), I_AIN = (D / 64) * (PROJW / 32), I_SQ = (D / 64) * (D / 32), I_KV = (D / 64) * (1536 / 32), I_MKV = (D / 64) * (512 / 32);
__device__ __forceinline__ int job_items(int j) { return j < 4 ? I_W1 : j < 8 ? I_W2 : j == 8 ? I_AIN : j == 10 ? I_KV : j < 13 ? I_SQ : j < 15 ? I_MKV : 0; }
__device__ __forceinline__ void convert_chunk(ArgsP ap, LAS float* scr, int gw, int NGW, int lane, int chunk) {
    typedef const float* cfp_t; const __attribute__((address_space(4))) cfp_t* in = (const __attribute__((address_space(4))) cfp_t*)ap->in;
    bf16* WB = (bf16*)(ap->ws + WS_W);
    const unsigned packed = chunk == 0 ? 0xED40u : chunk == 1 ? 0xA198u : chunk == 2 ? 0xCB25u : 0xF736u;
    const int j0 = packed & 15, j1 = (packed >> 4) & 15, j2 = (packed >> 8) & 15, j3 = (packed >> 12) & 15;
    const int n0 = job_items(j0), n1 = job_items(j1), n2 = job_items(j2), n3 = job_items(j3), total = n0 + n1 + n2 + n3;
    for (int it = gw; it < total; it += NGW) {
        int r = it, j = j0;
        if (r >= n0) { r -= n0; j = j1; if (r >= n1) { r -= n1; j = j2; if (r >= n2) { r -= n2; j = j3; } } }
        WJob J;
        if (j < 4) { const int l = j >> 1, post = j & 1;
            J.W = in[post ? 19 : 4] + (size_t)l * D * 2 * FF; J.gain = in[post ? 18 : 3] + l * D; J.Wt = WB + (j == 0 ? WO_W1_0 : j == 1 ? WO_W1_1 : j == 2 ? WO_W1_2 : WO_W1_3); J.K = D; J.N = 2 * FF; J.mode = 1; }
        else if (j < 8) { const int i = j - 4, l = i >> 1, post = i & 1;
            J.W = in[post ? 20 : 5] + (size_t)l * FF * D; J.gain = nullptr; J.Wt = WB + WO_W2 + (size_t)i * W2_SZ; J.K = FF; J.N = D; J.mode = 0; }
        else if (j == 8) { J.W = in[9]; J.gain = in[6]; J.Wt = WB + WO_AIN; J.K = D; J.N = PROJW; J.mode = 0; }
        else if (j == 9) { J.W = in[11]; J.gain = nullptr; J.Wt = WB + WO_AOUT; J.K = D; J.N = D; J.mode = 0; }
        else if (j == 10) { J.W = in[13]; J.gain = in[12]; J.Wt = WB + WO_KV; J.K = D; J.N = 1536; J.mode = 2; }
        else if (j == 11) { J.W = in[14]; J.gain = in[6] + D; J.Wt = WB + WO_Q; J.K = D; J.N = D; J.mode = 2; }
        else if (j == 12) { J.W = in[17]; J.gain = nullptr; J.Wt = WB + WO_BOUT; J.K = D; J.N = D; J.mode = 0; }
        else { const int l = j - 13; J.W = in[8] + (size_t)l * D * 512; J.gain = in[7] + l * D; J.Wt = WB + WO_MKV + (size_t)l * 512 * D; J.K = D; J.N = 512; J.mode = 0; }
        transpose_item(J, scr, r, lane);
    }
}
__device__ __forceinline__ void tail_convert(ArgsP ap, LAS unsigned char* lds, int M, int N, int G, int bx, int tid, int chunk, int tskip) {
    int rem = ((M / 256) * (N / 256)) % G;
    if (chunk <= 0 || rem == 0) return;
    rem += tskip; if (bx < rem || rem >= G) return;
    const int lane = tid & 63, wave = tid >> 6;
    convert_chunk(ap, (LAS float*)(lds + wave * 16384), (bx - rem) * NWAVES + wave, (G - rem) * NWAVES, lane, chunk);
    __syncthreads();
}
__device__ __forceinline__ void prep_phase(ArgsP ap, LAS unsigned char* lds, int vcu, int G, int tid) {
    const int lane = tid & 63, wave = tid >> 6;
    LAS float* scr = (LAS float*)(lds + wave * 16384);
    const int gw = vcu * NWAVES + wave, NGW = G * NWAVES;
    unsigned char* ws = ap->ws;
    typedef const float* cfp_t; const __attribute__((address_space(4))) cfp_t* in = (const __attribute__((address_space(4))) cfp_t*)ap->in;
    convert_chunk(ap, scr, gw, NGW, lane, 0);
    { const float* x = in[0]; bf16* hb = (bf16*)(ws + WS_HB); float* ssq = (float*)(ws + WS_SSQ);
      for (int m = gw; m < T; m += NGW) row_to_bf16(x + (size_t)m * D, hb + (size_t)m * D, ssq + (size_t)m * 4, lane);
      const float* mem = in[1]; bf16* mb = (bf16*)(ws + WS_MEMB); float* sm = (float*)(ws + WS_SSQM);
      for (int m = gw; m < BATCH * NMEM; m += NGW) row_to_bf16(mem + (size_t)m * D, mb + (size_t)m * D, sm + (size_t)m * 4, lane); }
    { const int* pos = (const int*)ap->in[2]; float* cs = (float*)(ws + WS_CS);
      for (int idx = vcu * NTHR + tid; idx < T * 8; idx += G * NTHR) { const int t = idx >> 3, i = idx & 7;
          const float invf = i == 0 ? 1.0f : i == 1 ? 0x1.8d275ep-3f : i == 2 ? 0x1.341190p-5f : i == 3 ? 0x1.ddee9cp-8f : i == 4 ? 0x1.72ba44p-10f : i == 5 ? 0x1.1f91f0p-12f : i == 6 ? 0x1.be2188p-15f : 0x1.5a0f4ep-17f;
          const float ang = (float)pos[t] * invf;
          double rev = (double)ang * 0.15915494309189533577; rev -= __builtin_floor(rev); const float f = (float)rev;
          cs[(size_t)t * 16 + i] = __builtin_amdgcn_cosf(f); cs[(size_t)t * 16 + 8 + i] = __builtin_amdgcn_sinf(f); } }
}

constexpr int MA_KS = 72, MA_VS = 264;
__device__ __forceinline__ void mem_attn_unit(LAS unsigned char* lds, const bf16* Q, int pq, const bf16* KV, bf16* Y, int py, int b, int h, int tb, int tid) {
    LAS bf16* Ks = (LAS bf16*)lds; LAS bf16* Vt = (LAS bf16*)(lds + 256 * MA_KS * 2);
    __syncthreads();
#pragma unroll
    for (int i = 0; i < 4; ++i) { const int idx = tid + NTHR * i, row = idx >> 3, chn = idx & 7;
        const bf16* src = KV + (size_t)(b * NMEM + row) * 512 + h * 64 + chn * 8;
        const v4u kk = *(const v4u*)src; *(LAS v4u*)(Ks + row * MA_KS + chn * 8) = kk;
        const v4u vv = *(const v4u*)(src + 256);
#pragma unroll
        for (int j = 0; j < 4; ++j) { Vt[(chn * 8 + 2 * j) * MA_VS + row] = (bf16)(vv[j] & 0xffffu); Vt[(chn * 8 + 2 * j + 1) * MA_VS + row] = (bf16)(vv[j] >> 16); } }
    __syncthreads();
    const int lane = tid & 63, wid = tid >> 6, r32 = lane & 31, hi = lane >> 5;
    const size_t t0 = (size_t)b * SEQ + tb * 256 + wid * 32;
    const bf16* qp = Q + (t0 + r32) * pq + h * 64 + hi * 8;
    bf16x8 qr[4];
#pragma unroll
    for (int d0 = 0; d0 < 4; ++d0) qr[d0] = *(const bf16x8*)(qp + d0 * 16);
    f32x16 s[8];
#pragma unroll
    for (int kb = 0; kb < 8; ++kb) { s[kb] = f32x16{};
#pragma unroll
        for (int d0 = 0; d0 < 4; ++d0) { const bf16x8 a = *(const LAS bf16x8*)(Ks + (kb * 32 + r32) * MA_KS + d0 * 16 + hi * 8); s[kb] = __builtin_amdgcn_mfma_f32_32x32x16_bf16(a, qr[d0], s[kb], 0, 0, 0); } }
    float mx = s[0][0];
#pragma unroll
    for (int kb = 0; kb < 8; ++kb)
#pragma unroll
        for (int r = 0; r < 16; ++r) mx = fmaxf(mx, s[kb][r]);
    mx = fmaxf(mx, __shfl_xor(mx, 32));
    const float mc = mx * C2; float l = 0.f;
    f32x16 o[2]; o[0] = f32x16{}; o[1] = f32x16{};
#pragma unroll
    for (int kb = 0; kb < 8; ++kb) {
#pragma unroll
        for (int r = 0; r < 16; ++r) { const float p = __builtin_amdgcn_exp2f(s[kb][r] * C2 - mc); s[kb][r] = p; l += p; }
#pragma unroll
        for (int s2 = 0; s2 < 2; ++s2) { v4u pw; pw.x = pk2(s[kb][8 * s2 + 0], s[kb][8 * s2 + 1]); pw.y = pk2(s[kb][8 * s2 + 2], s[kb][8 * s2 + 3]); pw.z = pk2(s[kb][8 * s2 + 4], s[kb][8 * s2 + 5]); pw.w = pk2(s[kb][8 * s2 + 6], s[kb][8 * s2 + 7]);
            const bf16x8 pb = __builtin_bit_cast(bf16x8, pw);
#pragma unroll
            for (int db = 0; db < 2; ++db) { const LAS bf16* vp = Vt + (db * 32 + r32) * MA_VS + kb * 32 + 16 * s2 + 4 * hi;
                const s16x4 lo = *(const LAS s16x4*)vp, hh = *(const LAS s16x4*)(vp + 8);
                const bf16x8 a = (bf16x8){lo[0], lo[1], lo[2], lo[3], hh[0], hh[1], hh[2], hh[3]};
                o[db] = __builtin_amdgcn_mfma_f32_32x32x16_bf16(a, pb, o[db], 0, 0, 0); } }
        __builtin_amdgcn_sched_barrier(0);
    }
    l += __shfl_xor(l, 32);
    const float inv = 1.0f / l;
    bf16* yp = Y + (t0 + r32) * py + h * 64 + 4 * hi;
#pragma unroll
    for (int db = 0; db < 2; ++db)
#pragma unroll
        for (int g = 0; g < 4; ++g) { v2u w; w.x = pk2(o[db][4 * g] * inv, o[db][4 * g + 1] * inv); w.y = pk2(o[db][4 * g + 2] * inv, o[db][4 * g + 3] * inv); *(v2u*)(yp + db * 32 + 8 * g) = w; }
}
__device__ __forceinline__ void mem_attn_phase(LAS unsigned char* lds, const bf16* Q, int pq, const bf16* KV, bf16* Y, int py, int vcu, int G, int tid) {
    for (int u = vcu; u < BATCH * 4 * (SEQ / 256); u += G) { const int tb = u & 31, h = (u >> 5) & 3, b = u >> 7; mem_attn_unit(lds, Q, pq, KV, Y, py, b, h, tb, tid); }
    __syncthreads();
}

__device__ __forceinline__ void unpack8(const v4u w, float* f) { f[0] = bf_lo(w.x); f[1] = bf_hi(w.x); f[2] = bf_lo(w.y); f[3] = bf_hi(w.y); f[4] = bf_lo(w.z); f[5] = bf_hi(w.z); f[6] = bf_lo(w.w); f[7] = bf_hi(w.w); }
__device__ __forceinline__ void conv_phase(const bf16* proj, bf16* y, const float* cw, int vcu, int G, int tid) {
    constexpr int RUN = 16, NCG = MIX / 8;
    for (int it = vcu * NTHR + tid; it < (T / RUN) * NCG; it += G * NTHR) {
        const int r = it / NCG, cg = it % NCG, t0 = r * RUN, ch = cg * 8;
        float w0[8], w1[8], w2[8], c1[8], c2[8];
#pragma unroll
        for (int i = 0; i < 8; ++i) { w0[i] = cw[ch + i]; w1[i] = cw[MIX + ch + i]; w2[i] = cw[2 * MIX + ch + i]; c1[i] = 0.f; c2[i] = 0.f; }
        if ((t0 & (SEQ - 1)) != 0) { float a[8], bq[8];
            const bf16* p2 = proj + (size_t)(t0 - 2) * PROJW + ch;
            unpack8(*(const v4u*)(p2 + MIX), a); unpack8(*(const v4u*)(p2 + 2 * MIX), bq);
#pragma unroll
            for (int i = 0; i < 8; ++i) c2[i] = a[i] * bq[i];
            unpack8(*(const v4u*)(p2 + PROJW + MIX), a); unpack8(*(const v4u*)(p2 + PROJW + 2 * MIX), bq);
#pragma unroll
            for (int i = 0; i < 8; ++i) c1[i] = a[i] * bq[i]; }
#pragma unroll 4
        for (int tt = 0; tt < RUN; ++tt) { const bf16* p = proj + (size_t)(t0 + tt) * PROJW + ch; float bg[8], cc[8], xx[8], o[8];
            unpack8(__builtin_nontemporal_load((const v4u*)p), bg); unpack8(__builtin_nontemporal_load((const v4u*)(p + MIX)), cc); unpack8(__builtin_nontemporal_load((const v4u*)(p + 2 * MIX)), xx);
#pragma unroll
            for (int i = 0; i < 8; ++i) { const float cx = cc[i] * xx[i]; o[i] = bg[i] * (w0[i] * c2[i] + w1[i] * c1[i] + w2[i] * cx); c2[i] = c1[i]; c1[i] = cx; }
            v4u w; w.x = pk2(o[0], o[1]); w.y = pk2(o[2], o[3]); w.z = pk2(o[4], o[5]); w.w = pk2(o[6], o[7]);
            st16_wt(y + (size_t)(t0 + tt) * D + ch, w); }
    }
}

__device__ __forceinline__ void combine_phase(const bf16* Ob, bf16* y, const float* lamp, const float* subln, int vcu, int G, int tid) {
    const int lane = tid & 63;
    const float d01 = wave_sum(lamp[lane] * lamp[64 + lane]), d23 = wave_sum(lamp[128 + lane] * lamp[192 + lane]);
    const float lam = expf(d01) - expf(d23) + LAM_INIT;
    const int sub = tid & 15, e = sub * 8;
    float gsub[8];
#pragma unroll
    for (int i = 0; i < 8; ++i) gsub[i] = subln[e + i] * (1.0f - LAM_INIT);
    for (int it = (vcu * NTHR + tid) >> 4; it < T * 6; it += (G * NTHR) >> 4) { const int t = it / 6, h = it % 6;
        const size_t off = (size_t)t * MIX + h * 128 + e; float a[8], bq[8], o[8]; float ss = 0.f;
        unpack8(__builtin_nontemporal_load((const v4u*)(Ob + off)), a); unpack8(__builtin_nontemporal_load((const v4u*)(Ob + (size_t)T * MIX + off)), bq);
#pragma unroll
        for (int i = 0; i < 8; ++i) { o[i] = a[i] - lam * bq[i]; ss += o[i] * o[i]; }
        ss += __shfl_xor(ss, 1); ss += __shfl_xor(ss, 2); ss += __shfl_xor(ss, 4); ss += __shfl_xor(ss, 8);
        const float rs = 1.0f / sqrtf(ss * (1.0f / 128.0f) + EPS);
        v4u w; w.x = pk2(o[0] * rs * gsub[0], o[1] * rs * gsub[1]); w.y = pk2(o[2] * rs * gsub[2], o[3] * rs * gsub[3]); w.z = pk2(o[4] * rs * gsub[4], o[5] * rs * gsub[5]); w.w = pk2(o[6] * rs * gsub[6], o[7] * rs * gsub[7]);
        st16_wt(y + (size_t)t * D + h * 128 + e, w); }
}
__device__ __forceinline__ void final_phase(float* out, const float* g, const bf16* hb, int vcu, int G, int tid) {
    const int lane = tid & 63, gw = vcu * NWAVES + (tid >> 6), NGW = G * NWAVES;
    f32x4 gv[4];
#pragma unroll
    for (int j = 0; j < 4; ++j) gv[j] = ((const f32x4*)g)[2 * lane + (j & 1) + 128 * (j >> 1)];
    for (int m = gw; m < T; m += NGW) { const v4u* hr = (const v4u*)(hb + (size_t)m * D) + lane; f32x4 v[4]; float s = 0.f;
#pragma unroll
        for (int j = 0; j < 2; ++j) { const v4u w = hr[64 * j]; v[2 * j] = (f32x4){bf_lo(w.x), bf_hi(w.x), bf_lo(w.y), bf_hi(w.y)}; v[2 * j + 1] = (f32x4){bf_lo(w.z), bf_hi(w.z), bf_lo(w.w), bf_hi(w.w)}; }
#pragma unroll
        for (int j = 0; j < 4; ++j) s += (v[j][0] * v[j][0] + v[j][1] * v[j][1]) + (v[j][2] * v[j][2] + v[j][3] * v[j][3]);
        const float rs = __builtin_amdgcn_rsqf(wave_sum(s) * (1.0f / D) + EPS);
        f32x4* orow = (f32x4*)(out + (size_t)m * D);
#pragma unroll
        for (int j = 0; j < 4; ++j) orow[2 * lane + (j & 1) + 128 * (j >> 1)] = v[j] * rs * gv[j]; }
}

#define RLX_AGENT __ATOMIC_RELAXED, __HIP_MEMORY_SCOPE_AGENT
#define XB_TMO      128
#define XB_XCNT(j)  (256  + 64 * (j))
#define XB_XSUB(j)  (1280 + 64 * (j))
#define XB_XGEN(j)  (2304 + 64 * (j))
#define XB_TOP      3328
#define XB_TOPGEN   3392
#define XCD_BAR_WORDS 3456
#define XB_SPIN_CAP (1u << 18)

__device__ __forceinline__ unsigned xb_ld(unsigned* p)              { return __hip_atomic_load(p, __ATOMIC_RELAXED, __HIP_MEMORY_SCOPE_AGENT); }
__device__ __forceinline__ unsigned xb_add(unsigned* p, unsigned v) { return __hip_atomic_fetch_add(p, v, __ATOMIC_RELAXED, __HIP_MEMORY_SCOPE_AGENT); }
__device__ __forceinline__ unsigned xb_xcc_id() { return (unsigned)__builtin_amdgcn_s_getreg((3 << 11) | 20) & 0xFu; }
#define XB_SPIN(cond, bar) do { unsigned _sp = 0; while (cond) { __builtin_amdgcn_s_sleep(1); \
    if ((++_sp & 255u) == 0u) { if (xb_ld(&(bar)[XB_TMO])) break; if (_sp > XB_SPIN_CAP) { atomicAdd(&(bar)[XB_TMO], 1u); break; } } } } while (0)

struct XcdBarrier {
    unsigned* bar; unsigned x;
    volatile LAS unsigned* st;
};

__device__ __forceinline__ XcdBarrier xcd_barrier_post(unsigned* bar, volatile LAS unsigned* st) {
    XcdBarrier b; b.bar = bar; b.x = xb_xcc_id(); b.st = st;
    if (threadIdx.x == 0) (void)xb_add(&bar[XB_XCNT(b.x)], 1u);
    return b;
}
__device__ __forceinline__ void xcd_barrier_complete(unsigned* bar, unsigned x, unsigned& nloc, unsigned& nx) {
    const unsigned G = gridDim.x * gridDim.y * gridDim.z;
    unsigned sum, cnt, mine, sp = 0u;
    for (;;) {
        sum = 0u; cnt = 0u; mine = 0u;
#pragma unroll
        for (unsigned j = 0; j < 16; ++j) { const unsigned c = xb_ld(&bar[XB_XCNT(j)]); sum += c; cnt += (c > 0u) ? 1u : 0u; mine = (j == x) ? c : mine; }
        if (sum == G) break;
        __builtin_amdgcn_s_sleep(1);
        if ((++sp & 255u) == 0u) { if (xb_ld(&bar[XB_TMO])) break; if (sp > XB_SPIN_CAP) { atomicAdd(&bar[XB_TMO], 1u); break; } }
    }
    nloc = mine > 0u ? mine : 1u; nx = cnt > 0u ? cnt : 1u;
}

__device__ __forceinline__ void xcd_barrier(const XcdBarrier& b) {
    asm volatile("s_waitcnt vmcnt(0)" ::: "memory");
    __syncthreads();
    if (threadIdx.x == 0) {
        unsigned* bar = b.bar;
        __builtin_amdgcn_s_waitcnt(0);
        unsigned nloc = b.st[0], nx = b.st[1];
        if (nloc == 0u) { xcd_barrier_complete(bar, b.x, nloc, nx); b.st[0] = nloc; b.st[1] = nx; }
        const unsigned old = xb_add(&bar[XB_XSUB(b.x)], 1u);
        const unsigned gen = old / nloc;
        if (old + 1u == (gen + 1u) * nloc) {
            asm volatile("buffer_wbl2 sc1\n\tbuffer_inv sc1\n\ts_waitcnt vmcnt(0)" ::: "memory");
            const unsigned og = xb_add(&bar[XB_TOP], 1u);
            const unsigned tg = og / nx;
            if (og + 1u == (tg + 1u) * nx) xb_add(&bar[XB_TOPGEN], 1u);
            else XB_SPIN(xb_ld(&bar[XB_TOPGEN]) == tg, bar);
            xb_add(&bar[XB_XGEN(b.x)], 1u);
            asm volatile("s_waitcnt vmcnt(0)" ::: "memory");
        } else {
            asm volatile("buffer_inv sc1" ::: "memory");
            XB_SPIN(xb_ld(&bar[XB_XGEN(b.x)]) == gen, bar);
            asm volatile("s_waitcnt vmcnt(0)" ::: "memory");
        }
    }
    __syncthreads();
}

__global__ void __launch_bounds__(NTHR, 2) mk_fwd(Args args) {
    extern __shared__ __attribute__((aligned(16))) unsigned char lds_raw[];
    LAS unsigned char* lds = (LAS unsigned char*)lds_raw;
    const int G = gridDim.x, bx = blockIdx.x;
    const int vcu = (G % 8 == 0) ? (bx % 8) * (G / 8) + bx / 8 : bx;
    volatile LAS unsigned* bst = (volatile LAS unsigned*)(lds + LDS_BYTES - 64);
    if (threadIdx.x < 2) bst[threadIdx.x] = 0u;
    __syncthreads();
    const XcdBarrier bar = xcd_barrier_post((unsigned*)args.ws, bst);
    const int s_lo = args.lo, s_hi = args.hi;
    for (int si = s_lo; si < s_hi; ++si) {
        ArgsP ap = (ArgsP)__builtin_amdgcn_kernarg_segment_ptr(); asm volatile("" : "+s"(ap));
        const __attribute__((address_space(4))) Step& st = ap->steps[si];
        int tid = threadIdx.x; asm volatile("" : "+v"(tid));
        const int kind = st.kind;
#ifndef MK_KMASK
#define MK_KMASK 0x1ff
#endif
#define KON(k) ((MK_KMASK >> (k)) & 1)
        if (KON(K_PREP) && kind == K_PREP) prep_phase(ap, lds, vcu, G, tid);
        else if (KON(K_SWIGLU) && kind == K_SWIGLU) { pg8::Gemm g{(const pg8::bf16_t*)st.A, (const pg8::bf16_t*)st.Bt, st.M, st.N, st.K}; pg8::StaticOrder S; S.init(st.M, st.N, G, bx);
            pg8::EpiSwiGLU E{(pg8::bf16_t*)st.p0, st.ldc, (const float*)st.p1, st.pad, (pg8::bf16_t*)st.p2, 1536, (const float*)st.p3}; pg8::gemm_phase<pg8::EpiSwiGLU, pg8::StaticOrder, true, true>(lds, g, S, E); tail_convert(ap, lds, st.M, st.N, G, bx, tid, (int)st.scale, st.tskip); }
        else if (KON(K_RES) && kind == K_RES) { pg8::Gemm g{(const pg8::bf16_t*)st.A, (const pg8::bf16_t*)st.Bt, st.M, st.N, st.K}; pg8::StaticOrder S; S.init(st.M, st.N, G, bx);
            pg8::EpiRes E{(pg8::bf16_t*)st.p2, (float*)st.p3, st.scale, (PG8_LAS float*)(lds + 131072)}; pg8::gemm_phase<pg8::EpiRes, pg8::StaticOrder, true, true>(lds, g, S, E); }
        else if (KON(K_SCALE) && kind == K_SCALE) { pg8::Gemm g{(const pg8::bf16_t*)st.A, (const pg8::bf16_t*)st.Bt, st.M, st.N, st.K}; pg8::StaticOrder S; S.init(st.M, st.N, G, (bx - st.coff + G) % G);
            pg8::EpiScale E{(pg8::bf16_t*)st.p0, st.ldc, (const float*)st.p1}; pg8::gemm_phase<pg8::EpiScale, pg8::StaticOrder, true, true>(lds, g, S, E); tail_convert(ap, lds, st.M, st.N, G, bx, tid, (int)st.scale, st.tskip); }
        else if (KON(K_ROPE) && kind == K_ROPE) { pg8::Gemm g{(const pg8::bf16_t*)st.A, (const pg8::bf16_t*)st.Bt, st.M, st.N, st.K}; pg8::StaticOrder S; S.init(st.M, st.N, G, bx);
            pg8::EpiRope E{(pg8::bf16_t*)st.p0, st.ldc, (const float*)st.p1, (const float*)st.p2, st.scale}; pg8::gemm_phase<pg8::EpiRope, pg8::StaticOrder, true, true>(lds, g, S, E); }
        else if (KON(K_MIXA) && kind == K_MIXA) { conv_phase((const bf16*)st.A, (bf16*)st.p0, (const float*)st.p1, vcu, G, tid);
            mem_attn_phase(lds, (const bf16*)st.A + 3 * MIX, PROJW, (const bf16*)st.p2, (bf16*)st.p0 + MIX, D, vcu, G, tid); }
        else if (KON(K_ATTN) && kind == K_ATTN) { attn_body::attn_phase<8>((char*)lds_raw, (const attn_body::bf16*)st.A, (const attn_body::bf16*)st.Bt, (const attn_body::bf16*)st.Bt + MIX, (attn_body::bf16*)st.p0, vcu, G); }
        else if (KON(K_COMB) && kind == K_COMB) { combine_phase((const bf16*)st.A, (bf16*)st.p0, (const float*)st.p1, (const float*)st.p2, vcu, G, tid);
            mem_attn_phase(lds, (const bf16*)st.p0 + MIX, D, (const bf16*)st.p3, (bf16*)st.p0 + MIX, D, vcu, G, tid); }
        else if (KON(K_FINAL) && kind == K_FINAL) final_phase((float*)st.p0, (const float*)st.p1, (const bf16*)st.p2, vcu, G, tid);
        if (st.sync_after && si + 1 < s_hi) xcd_barrier(bar);
    }
}

#ifndef MK_ONE_LAUNCH
#define MK_ONE_LAUNCH 1
#endif
extern "C" void kernel_launch(void* const* d_in, const int* in_sizes, int n_in, void* d_out, int out_size, void* d_ws, size_t ws_size, hipStream_t stream) {
    static int grid = 0;
    if (grid == 0) {
        if (n_in != 22 || in_sizes[0] != T * D || out_size != T * D || ws_size < WS_END) { fprintf(stderr, "kernel_launch: unexpected problem (n_in %d, in0 %d, out %d, ws %zu)\n", n_in, n_in > 0 ? in_sizes[0] : -1, out_size, ws_size); grid = -1; return; }
        int dev = 0, cus = 0, per_cu = 0;
        if (hipGetDevice(&dev) != hipSuccess || hipDeviceGetAttribute(&cus, hipDeviceAttributeMultiprocessorCount, dev) != hipSuccess) { grid = -1; return; }
        if (hipFuncSetAttribute((const void*)mk_fwd, hipFuncAttributeMaxDynamicSharedMemorySize, LDS_BYTES) != hipSuccess) { fprintf(stderr, "kernel_launch: hipFuncSetAttribute failed\n"); grid = -1; return; }
        if (hipOccupancyMaxActiveBlocksPerMultiprocessor(&per_cu, (const void*)mk_fwd, NTHR, LDS_BYTES) != hipSuccess || per_cu < 1) { fprintf(stderr, "kernel_launch: occupancy query says %d\n", per_cu); per_cu = 1; }
        (void)hipGetLastError();
        grid = cus;
    }
    if (grid < 0) return;
    unsigned char* ws = (unsigned char*)d_ws; bf16* WB = (bf16*)(ws + WS_W);
    bf16* hb = (bf16*)(ws + WS_HB); bf16* act = (bf16*)(ws + WS_ACT); bf16* kvb = (bf16*)(ws + WS_KV); bf16* y0 = (bf16*)(ws + WS_KV); bf16* qb = (bf16*)(ws + WS_ACT); bf16* ob = (bf16*)(ws + WS_OB);
    float* ssq = (float*)(ws + WS_SSQ); float* cs = (float*)(ws + WS_CS); bf16* memb = (bf16*)(ws + WS_MEMB); bf16* memkv = (bf16*)(ws + WS_MEMKV); float* ssqm = (float*)(ws + WS_SSQM);
    float* out = (float*)d_out;
    Args a{}; int n = 0;
    auto add = [&](int kind, int sync, int M, int N, int K, int ldc, float scale, const void* A, const void* Bt, void* p0, void* p1, void* p2, void* p3) {
        Step& s = a.steps[n++]; s.kind = kind; s.sync_after = sync; s.M = M; s.N = N; s.K = K; s.ldc = ldc; s.scale = scale; s.pad = 0; s.coff = 0; s.tskip = 0; s.A = A; s.Bt = Bt; s.p0 = p0; s.p1 = p1; s.p2 = p2; s.p3 = p3; };
    add(K_PREP, 1, 0, 0, 0, 0, 0.f, nullptr, nullptr, nullptr, nullptr, nullptr, nullptr);
    add(K_SCALE, 0, 512, 512, D, 512, 0.f, memb, WB + WO_MKV, memkv, ssqm, nullptr, nullptr); a.steps[n - 1].coff = 128;
    add(K_SCALE, 0, 512, 512, D, 512, 0.f, memb, WB + WO_MKV + (size_t)512 * D, memkv + 512 * 512, ssqm, nullptr, nullptr); a.steps[n - 1].coff = 132;
    add(K_SWIGLU, 1, T, 2 * FF, D, FF, 1.f, hb, WB + WO_W1_0, act, ssq, nullptr, nullptr); a.steps[n - 1].tskip = 8;
    add(K_RES, 1, T, D, FF, D, 0.5f, act, WB + WO_W2, nullptr, nullptr, hb, ssq);
    add(K_SCALE, 1, T, PROJW, D, PROJW, 2.f, hb, WB + WO_AIN, act, ssq, nullptr, nullptr);
    add(K_MIXA, 1, 0, 0, 0, 0, 0.f, act, nullptr, y0, (void*)d_in[10], memkv, nullptr);
    add(K_RES, 1, T, D, D, D, 1.0f, y0, WB + WO_AOUT, nullptr, nullptr, hb, ssq);
    add(K_SWIGLU, 1, T, 2 * FF, D, FF, 3.f, hb, WB + WO_W1_1, act, ssq, nullptr, nullptr);
    add(K_RES, 1, T, D, FF, D, 0.5f, act, WB + WO_W2 + W2_SZ, nullptr, nullptr, hb, ssq);
    add(K_SWIGLU, 1, T, 1536 + 2 * FF, D, FF, 0.f, hb, WB + WO_KV, act, ssq, kvb, cs); a.steps[n - 1].pad = 6;
    add(K_RES, 1, T, D, FF, D, 0.5f, act, WB + WO_W2 + 2 * W2_SZ, nullptr, nullptr, hb, ssq);
    add(K_ROPE, 1, T, D, D, D, C2, hb, WB + WO_Q, qb, ssq, cs, nullptr);
    add(K_ATTN, 1, 0, 0, 0, 0, 0.f, qb, kvb, ob, nullptr, nullptr, nullptr);
    add(K_COMB, 1, 0, 0, 0, 0, 0.f, ob, nullptr, qb, (void*)d_in[15], (void*)d_in[16], memkv + 512 * 512);
    add(K_RES, 1, T, D, D, D, 1.0f, qb, WB + WO_BOUT, nullptr, nullptr, hb, ssq);
    add(K_SWIGLU, 1, T, 2 * FF, D, FF, 0.f, hb, WB + WO_W1_3, act, ssq, nullptr, nullptr);
    add(K_RES, 1, T, D, FF, D, 0.5f, act, WB + WO_W2 + 3 * W2_SZ, nullptr, nullptr, hb, ssq);
    add(K_FINAL, 0, 0, 0, 0, 0, 0.f, nullptr, nullptr, out, (void*)d_in[21], hb, nullptr);
#ifndef MK_REPMASK
#define MK_REPMASK 0
#endif
#ifndef MK_EXTRASYNC
#define MK_EXTRASYNC 0
#endif
    if (MK_REPMASK || MK_EXTRASYNC) {
        Step tmp[MAX_STEPS]; int m = 0;
        for (int i = 0; i < n; ++i) { tmp[m++] = a.steps[i];
            if ((MK_REPMASK >> i) & 1) { if (!a.steps[i].sync_after) { tmp[m - 1].sync_after = 1; } Step d = a.steps[i]; d.sync_after = 1; if (d.kind == K_RES) { d.scale = 0.f; } tmp[m++] = d; }
            if (i == 5) for (int q = 0; q < MK_EXTRASYNC; ++q) { Step d{}; d.kind = 99; d.sync_after = 1; tmp[m++] = d; } }
        n = m; for (int i = 0; i < n; ++i) a.steps[i] = tmp[i];
    }
    for (int i = 0; i < 22; ++i) a.in[i] = d_in[i];
    a.out = out; a.ws = ws;
    if (hipMemsetAsync(ws + WS_CTL, 0, 16384, stream) != hipSuccess) { fprintf(stderr, "kernel_launch: memset failed\n"); return; }
#if MK_ONE_LAUNCH
    a.lo = 0; a.hi = n;
    void* kargs[] = {&a};
    hipError_t e = hipLaunchCooperativeKernel((const void*)mk_fwd, dim3(grid), dim3(NTHR), kargs, LDS_BYTES, stream);
    if (e != hipSuccess) fprintf(stderr, "kernel_launch: cooperative launch failed: %s\n", hipGetErrorString(e));
#else
    for (int lo = 0; lo < n;) { int hi = lo; while (hi < n && !a.steps[hi].sync_after) ++hi; if (hi < n) ++hi;
        a.lo = lo; a.hi = hi; hipLaunchKernelGGL(mk_fwd, dim3(grid), dim3(NTHR), LDS_BYTES, stream, a); lo = hi; }
#endif
}
```

```cpp
#include <hip/hip_runtime.h>
#include <cstdio>
#include <cstdint>
namespace pg8 {
#define PG8_LAS __attribute__((address_space(3)))
typedef unsigned short bf16_t;
typedef short bf16x8 __attribute__((ext_vector_type(8)));
typedef float f32x4 __attribute__((ext_vector_type(4)));
typedef unsigned u32x4 __attribute__((ext_vector_type(4)));
constexpr int BM = 256, BK = 64, HALF = 128, HTB = HALF * BK * 2  , STAGE_BYTES = 8 * HTB, NXCD = 8, WGM = 8;

__host__ __device__ __forceinline__ int lds_byte(int r, int c) { const int st = (r >> 4) * 2 + (c >> 5), rr = r & 15, cc = c & 31, ob = rr * 64 + cc * 2; return st * 1024 + (ob ^ (((ob >> 9) & 1) << 5)); }
__host__ __device__ __forceinline__ void stage_rc(int b, int& R, int& C) { const int st = b / 1024, sb = b % 1024, swz = sb ^ (((sb >> 9) & 1) << 5); R = (st >> 1) * 16 + swz / 64; C = (st & 1) * 32 + (swz % 64) / 2; }
__host__ __device__ __forceinline__ int perm32(int rho) { const int n = rho >> 4, i = rho & 15; return 8 * (i >> 2) + 4 * n + (i & 3); }

struct Unit { int pm, pn; };
struct Gemm { const bf16_t* A; const bf16_t* Bt; int M, N, K; };

struct StaticOrder {
    int nM, nN, nwg, G, c;
    __host__ __device__ void init(int M, int N, int G_, int c_) { nM = M / BM; nN = N / BM; nwg = nM * nN; G = G_; c = c_; }
    __host__ __device__ bool next(int i, Unit& u) const {
        const long L = (long)i * G + c; if (L >= nwg) return false;
        int wgid = (int)L; { const int q = nwg / NXCD, r = nwg % NXCD, xcd = wgid % NXCD, off = wgid / NXCD; wgid = (xcd < r ? xcd * (q + 1) : r * (q + 1) + (xcd - r) * q) + off; }
        const int nig = WGM * nN, gid = wgid / nig, fm = gid * WGM, gsz = (nM - fm) < WGM ? (nM - fm) : WGM;
        u.pm = fm + ((wgid % nig) % gsz); u.pn = (wgid % nig) / gsz; return true;
    }
    __device__ __forceinline__ void a_ready(const Unit&) const {}
    __device__ __forceinline__ void done(const Unit&) const {}
};
typedef float f32x2 __attribute__((ext_vector_type(2))); typedef __bf16 bf16x2_t __attribute__((ext_vector_type(2)));
__device__ __forceinline__ unsigned cvt_pk_bf16(float lo, float hi) { const f32x2 v = {lo, hi}; const bf16x2_t b = __builtin_convertvector(v, bf16x2_t); return __builtin_bit_cast(unsigned, b); }
constexpr float RMS_EPS = 1e-6f;
__device__ __forceinline__ void prefetch_stats(float (&pre)[8], const float* ssq, const Unit& u, int wr, int fr, int fq) {
    const float* p = ssq + (size_t)(u.pm * BM + wr * 64 + fr) * 4 + fq;
#pragma unroll
    for (int ai = 0; ai < 2; ++ai)
#pragma unroll
        for (int m = 0; m < 4; ++m) pre[ai * 4 + m] = p[(size_t)(ai * HALF + m * 16) * 4];
}
__device__ __forceinline__ float row_rstd(float part) {
    float s = part; s += __shfl_xor(s, 16); s += __shfl_xor(s, 32);
    return __builtin_amdgcn_rsqf(s * (1.0f / 1024.0f) + RMS_EPS);
}
__device__ __forceinline__ float silu_mul(float g, float u) { return g * u * __builtin_amdgcn_rcpf(1.0f + __builtin_amdgcn_exp2f(-1.4426950408889634f * g)); }
__device__ __forceinline__ void store16_wt(void* p, const u32x4 v) { asm volatile("global_store_dwordx4 %0, %1, off sc1\n\ts_nop 1" :: "v"(p), "v"(v) : "memory"); }
__device__ __forceinline__ u32x4 pack8(const f32x4 v0, const f32x4 v1) { u32x4 w; w.x = cvt_pk_bf16(v0[0], v0[1]); w.y = cvt_pk_bf16(v0[2], v0[3]); w.z = cvt_pk_bf16(v1[0], v1[1]); w.w = cvt_pk_bf16(v1[2], v1[3]); return w; }

struct EpiSwiGLU {
    static constexpr bool PERM = true, AFTER_DRAIN = false;
    bf16_t* O; int ldc; const float* ssq; int npre; bf16_t* O2; int ld2; const float* cs;
    __device__ __forceinline__ void prefetch(float (&pre)[8], const Unit& u, int wr, int fr, int fq) const { prefetch_stats(pre, ssq, u, wr, fr, fq); }
    __device__ __forceinline__ void operator()(const f32x4 (&acc)[2][2][4][2], const Unit& u, int wr, int wc, int fr, int fq, const float (&pre)[8]) const {
        const int row0 = u.pm * BM + wr * 64 + fr;
        if (u.pn < npre) {
            const int col0 = u.pn * BM + wc * 32 + 8 * fq; const bool rot = (u.pn < 3) && ((wc & 1) == 0) && (fq < 2);
#pragma unroll
            for (int ai = 0; ai < 2; ++ai)
#pragma unroll
                for (int m = 0; m < 4; ++m) { const int row = row0 + ai * HALF + m * 16; const float rs = row_rstd(pre[ai * 4 + m]);
                    f32x4 c4 = (f32x4){1.f, 1.f, 1.f, 1.f}, s4 = (f32x4){0.f, 0.f, 0.f, 0.f};
                    if (rot) { c4 = *(const f32x4*)(cs + (size_t)row * 16 + 4 * fq); s4 = *(const f32x4*)(cs + (size_t)row * 16 + 8 + 4 * fq); }
#pragma unroll
                    for (int bj = 0; bj < 2; ++bj) { const f32x4 v0 = acc[ai][bj][m][0] * rs, v1 = acc[ai][bj][m][1] * rs; f32x4 o0, o1;
                        o0[0] = v0[0] * c4[0] - v0[1] * s4[0]; o0[1] = v0[1] * c4[0] + v0[0] * s4[0]; o0[2] = v0[2] * c4[1] - v0[3] * s4[1]; o0[3] = v0[3] * c4[1] + v0[2] * s4[1];
                        o1[0] = v1[0] * c4[2] - v1[1] * s4[2]; o1[1] = v1[1] * c4[2] + v1[0] * s4[2]; o1[2] = v1[2] * c4[3] - v1[3] * s4[3]; o1[3] = v1[3] * c4[3] + v1[2] * s4[3];
                        store16_wt(O2 + (size_t)row * ld2 + col0 + bj * HALF, pack8(o0, o1)); } }
            return;
        }
        const int col0 = (u.pn - npre) * HALF + wc * 32 + 8 * fq;
#pragma unroll
        for (int ai = 0; ai < 2; ++ai)
#pragma unroll
            for (int m = 0; m < 4; ++m) { const int row = row0 + ai * HALF + m * 16; const float rs = row_rstd(pre[ai * 4 + m]), nt = rs * -1.4426950408889634f;
                f32x4 o[2];
#pragma unroll
                for (int n = 0; n < 2; ++n) { const f32x4 g = acc[ai][0][m][n], uu = acc[ai][1][m][n]; const f32x4 t = g * nt; f32x4 e;
                    e[0] = __builtin_amdgcn_exp2f(t[0]); e[1] = __builtin_amdgcn_exp2f(t[1]); e[2] = __builtin_amdgcn_exp2f(t[2]); e[3] = __builtin_amdgcn_exp2f(t[3]);
                    const f32x4 d = e + 1.0f; f32x4 r;
                    r[0] = __builtin_amdgcn_rcpf(d[0]); r[1] = __builtin_amdgcn_rcpf(d[1]); r[2] = __builtin_amdgcn_rcpf(d[2]); r[3] = __builtin_amdgcn_rcpf(d[3]);
                    o[n] = ((g * rs) * r) * (uu * rs); }
                store16_wt(O + (size_t)row * ldc + col0, pack8(o[0], o[1])); }
    }
};
__device__ __forceinline__ float bfl(unsigned w) { return __builtin_bit_cast(float, w << 16); }
__device__ __forceinline__ float bfh(unsigned w) { return __builtin_bit_cast(float, w & 0xffff0000u); }
struct EpiRes {
    static constexpr bool PERM = true, AFTER_DRAIN = false;
    bf16_t* hb; float* ssq; float scale; PG8_LAS float* red;
    __device__ __forceinline__ void prefetch(float (&pre)[8], const Unit&, int, int, int) const {}
    __device__ __forceinline__ void operator()(const f32x4 (&acc)[2][2][4][2], const Unit& u, int wr, int wc, int fr, int fq, const float (&pre)[8]) const {
        const int rl0 = wr * 64 + fr, row0 = u.pm * BM + rl0, col0 = u.pn * BM + wc * 32 + 8 * fq;
#pragma unroll
        for (int ai = 0; ai < 2; ++ai)
#pragma unroll
            for (int m = 0; m < 4; ++m) { const int row = row0 + ai * HALF + m * 16; bf16_t* p = hb + (size_t)row * 1024 + col0; float ss = 0.f;
#pragma unroll
                for (int bj = 0; bj < 2; ++bj) { const u32x4 w = *(const u32x4*)(p + bj * HALF);
                    const f32x4 b0 = (f32x4){bfl(w.x), bfh(w.x), bfl(w.y), bfh(w.y)}, b1 = (f32x4){bfl(w.z), bfh(w.z), bfl(w.w), bfh(w.w)};
                    const f32x4 o0 = b0 + acc[ai][bj][m][0] * scale, o1 = b1 + acc[ai][bj][m][1] * scale;
                    store16_wt(p + bj * HALF, pack8(o0, o1));
                    const f32x4 q = o0 * o0 + o1 * o1; ss += (q[0] + q[1]) + (q[2] + q[3]); }
                ss += __shfl_xor(ss, 16); ss += __shfl_xor(ss, 32);
                if (fq == 0) red[(rl0 + ai * HALF + m * 16) * 4 + wc] = ss; }
        asm volatile("s_waitcnt lgkmcnt(0)" ::: "memory"); __builtin_amdgcn_s_barrier(); asm volatile("" ::: "memory");
        const int tid = (wr * 4 + wc) * 64 + fq * 16 + fr;
        if (tid < BM) { const f32x4 v = *(const PG8_LAS f32x4*)(red + tid * 4); __hip_atomic_store(ssq + (size_t)(u.pm * BM + tid) * 4 + u.pn, (v[0] + v[1]) + (v[2] + v[3]), __ATOMIC_RELAXED, __HIP_MEMORY_SCOPE_AGENT); }
        asm volatile("s_waitcnt lgkmcnt(0)" ::: "memory"); __builtin_amdgcn_s_barrier(); asm volatile("" ::: "memory");
    }
};
struct EpiScale {
    static constexpr bool PERM = true, AFTER_DRAIN = false;
    bf16_t* O; int ldc; const float* ssq; int mlo, mhi;
    __device__ __forceinline__ void prefetch(float (&pre)[8], const Unit& u, int wr, int fr, int fq) const { prefetch_stats(pre, ssq, u, wr, fr, fq); }
    __device__ __forceinline__ void operator()(const f32x4 (&acc)[2][2][4][2], const Unit& u, int wr, int wc, int fr, int fq, const float (&pre)[8]) const {
        const int row0 = u.pm * BM + wr * 64 + fr;
        if (u.pn >= mlo && u.pn < mhi) {
            const int col0 = mlo * BM + (u.pn - mlo) * HALF + wc * 32 + 8 * fq;
#pragma unroll
            for (int ai = 0; ai < 2; ++ai)
#pragma unroll
                for (int m = 0; m < 4; ++m) { const int row = row0 + ai * HALF + m * 16; const float rs = row_rstd(pre[ai * 4 + m]), rs2 = rs * rs;
                    store16_wt(O + (size_t)row * ldc + col0, pack8(acc[ai][0][m][0] * acc[ai][1][m][0] * rs2, acc[ai][0][m][1] * acc[ai][1][m][1] * rs2)); }
            return;
        }
        const int col0 = (u.pn < mhi ? u.pn * BM : u.pn * BM - (mhi - mlo) * HALF) + wc * 32 + 8 * fq;
#pragma unroll
        for (int ai = 0; ai < 2; ++ai)
#pragma unroll
            for (int m = 0; m < 4; ++m) { const int row = row0 + ai * HALF + m * 16; const float rs = row_rstd(pre[ai * 4 + m]);
#pragma unroll
                for (int bj = 0; bj < 2; ++bj) store16_wt(O + (size_t)row * ldc + col0 + bj * HALF, pack8(acc[ai][bj][m][0] * rs, acc[ai][bj][m][1] * rs)); }
    }
};
struct EpiRope {
    static constexpr bool PERM = true, AFTER_DRAIN = false;
    bf16_t* O; int ldc; const float* ssq; const float* cs; float rscale;
    __device__ __forceinline__ void prefetch(float (&pre)[8], const Unit& u, int wr, int fr, int fq) const { prefetch_stats(pre, ssq, u, wr, fr, fq); }
    __device__ __forceinline__ void operator()(const f32x4 (&acc)[2][2][4][2], const Unit& u, int wr, int wc, int fr, int fq, const float (&pre)[8]) const {
        const int row0 = u.pm * BM + wr * 64 + fr, col0 = u.pn * BM + wc * 32 + 8 * fq;
        const bool ropet = u.pn < 3, rot = ropet && ((wc & 1) == 0) && (fq < 2);
        const float sc = ropet ? rscale : 1.0f;
#pragma unroll
        for (int ai = 0; ai < 2; ++ai)
#pragma unroll
            for (int m = 0; m < 4; ++m) { const int row = row0 + ai * HALF + m * 16; const float rs = row_rstd(pre[ai * 4 + m]) * sc;
                f32x4 c4 = (f32x4){1.f, 1.f, 1.f, 1.f}, s4 = (f32x4){0.f, 0.f, 0.f, 0.f};
                if (rot) { c4 = *(const f32x4*)(cs + (size_t)row * 16 + 4 * fq); s4 = *(const f32x4*)(cs + (size_t)row * 16 + 8 + 4 * fq); }
#pragma unroll
                for (int bj = 0; bj < 2; ++bj) { const f32x4 v0 = acc[ai][bj][m][0] * rs, v1 = acc[ai][bj][m][1] * rs; f32x4 o0, o1;
                    o0[0] = v0[0] * c4[0] - v0[1] * s4[0]; o0[1] = v0[1] * c4[0] + v0[0] * s4[0]; o0[2] = v0[2] * c4[1] - v0[3] * s4[1]; o0[3] = v0[3] * c4[1] + v0[2] * s4[1];
                    o1[0] = v1[0] * c4[2] - v1[1] * s4[2]; o1[1] = v1[1] * c4[2] + v1[0] * s4[2]; o1[2] = v1[2] * c4[3] - v1[3] * s4[3]; o1[3] = v1[3] * c4[3] + v1[2] * s4[3];
                    store16_wt(O + (size_t)row * ldc + col0 + bj * HALF, pack8(o0, o1)); } }
    }
};

template <class Epi, class Sched, bool ALIGN_EPI = false, bool SP2 = false>
__device__ __forceinline__ void gemm_phase(PG8_LAS unsigned char* lds, const Gemm g, const Sched& S, const Epi& E) {
    int tid_ = threadIdx.x; asm volatile("" : "+v"(tid_));
    const int tid = tid_, wid = __builtin_amdgcn_readfirstlane(tid >> 6), lane = tid & 63, wr = wid >> 2, wc = wid & 3, fr = lane & 15, fq = lane >> 4;
    const int K = g.K, nt = K / BK;
    unsigned voffA[2], voffB[2];
#pragma unroll
    for (int i = 0; i < 2; ++i) { int R, C; stage_rc(tid * 16 + i * 8192, R, C); const int Rb = Epi::PERM ? ((R & ~31) + perm32(R & 31)) : R;
        voffA[i] = (unsigned)(R * K + C) * 2u; voffB[i] = (unsigned)(Rb * K + C) * 2u; }
    const size_t kstep = (size_t)(BK * 2);
    const size_t hstep = (size_t)HALF * K * 2;
    const size_t tstep = 2 * hstep;
    const unsigned ldsw = (unsigned)wid * 1024u;
    const int aoff = lds_byte(wr * 64 + fr, fq * 8), boff = lds_byte(wc * 32 + fr, fq * 8);
#define PG8_SA(b, h) (((b) * 2 + (h)) * HTB)
#define PG8_SB(b, h) ((4 + (b) * 2 + (h)) * HTB)
#define PG8_STAGE(bufoff, gbase, voff) do { _Pragma("unroll") for (int _i = 0; _i < 2; ++_i) \
        __builtin_amdgcn_global_load_lds((const unsigned*)((const char*)(gbase) + (voff)[_i]), (PG8_LAS unsigned*)(lds + (bufoff) + ldsw + _i * 8192), 16, 0, 0); } while (0)
#define PG8_LDA(dst, b, h) do { _Pragma("unroll") for (int m = 0; m < 4; ++m) _Pragma("unroll") for (int k = 0; k < 2; ++k) dst[m][k] = *(const PG8_LAS bf16x8*)(lds + PG8_SA(b, h) + aoff + m * 2048 + k * 1024); } while (0)
#define PG8_LDB(dst, b, h) do { _Pragma("unroll") for (int n = 0; n < 2; ++n) _Pragma("unroll") for (int k = 0; k < 2; ++k) dst[n][k] = *(const PG8_LAS bf16x8*)(lds + PG8_SB(b, h) + boff + n * 2048 + k * 1024); } while (0)
#define PG8_MMA(ai, bj, At, Bt) do { __builtin_amdgcn_s_setprio(1); _Pragma("unroll") for (int m = 0; m < 4; ++m) _Pragma("unroll") for (int n = 0; n < 2; ++n) _Pragma("unroll") for (int k = 0; k < 2; ++k) \
        acc[ai][bj][m][n] = __builtin_amdgcn_mfma_f32_16x16x32_bf16(Bt[n][k], At[m][k], acc[ai][bj][m][n], 0, 0, 0); __builtin_amdgcn_s_setprio(0); } while (0)
#define PG8_WAIT_V(n) asm volatile("s_waitcnt vmcnt(" #n ")" ::: "memory")
#define PG8_WAIT_L(n) asm volatile("s_waitcnt lgkmcnt(" #n ")" ::: "memory")
#define PG8_BAR __builtin_amdgcn_s_barrier()
#define PG8_SCHED __builtin_amdgcn_sched_barrier(0)
    Unit cur, nxt; int ui = 0;
    if (!S.next(0, cur)) return;
    f32x4 acc[2][2][4][2];
#pragma unroll
    for (int a = 0; a < 2; ++a)
#pragma unroll
        for (int b = 0; b < 2; ++b)
#pragma unroll
            for (int m = 0; m < 4; ++m)
#pragma unroll
                for (int n = 0; n < 2; ++n) acc[a][b][m][n] = (f32x4){0.f, 0.f, 0.f, 0.f};
    bf16x8 At[4][2], B0[2][2], B1[2][2]; float pre[8] = {0.f, 0.f, 0.f, 0.f, 0.f, 0.f, 0.f, 0.f};
    const char* cA = (const char*)g.A + (size_t)cur.pm * tstep; const char* cB = (const char*)g.Bt + (size_t)cur.pn * tstep;
    S.a_ready(cur);
    E.prefetch(pre, cur, wr, fr, fq);
    if constexpr (SP2) {
        PG8_STAGE(PG8_SB(0, 0), cB, voffB); PG8_STAGE(PG8_SB(0, 1), cB + hstep, voffB); PG8_STAGE(PG8_SA(0, 0), cA, voffA); PG8_STAGE(PG8_SA(0, 1), cA + hstep, voffA);
        if (wr == 1) PG8_BAR;
        PG8_WAIT_V(2); PG8_BAR;
        PG8_STAGE(PG8_SB(1, 0), cB + kstep, voffB); PG8_STAGE(PG8_SA(1, 0), cA + kstep, voffA); PG8_STAGE(PG8_SB(1, 1), cB + hstep + kstep, voffB);
        PG8_WAIT_V(6); PG8_BAR;
    } else {
        PG8_STAGE(PG8_SB(0, 0), cB, voffB); PG8_STAGE(PG8_SA(0, 0), cA, voffA); PG8_STAGE(PG8_SB(0, 1), cB + hstep, voffB); PG8_STAGE(PG8_SA(0, 1), cA + hstep, voffA);
        if (wr == 1) PG8_BAR;
        PG8_WAIT_V(4); PG8_BAR;
        PG8_STAGE(PG8_SB(1, 0), cB + kstep, voffB); PG8_STAGE(PG8_SA(1, 0), cA + kstep, voffA); PG8_STAGE(PG8_SB(1, 1), cB + hstep + kstep, voffB);
        PG8_WAIT_V(6); PG8_BAR;
    }
    for (;;) {
        const bool has_next = S.next(ui + 1, nxt);
        const char* nA = has_next ? (const char*)g.A + (size_t)nxt.pm * tstep : cA; const char* nB = has_next ? (const char*)g.Bt + (size_t)nxt.pn * tstep : cB;
        for (int t = 0; t < nt; t += 2) {
            const bool last = (t == nt - 2);
            const char* a1 = cA + (size_t)(t + 1) * kstep;
            const char* a2 = last ? nA : cA + (size_t)(t + 2) * kstep; const char* b2 = last ? nB : cB + (size_t)(t + 2) * kstep;
            const char* a3 = a2 + kstep; const char* b3 = b2 + kstep;
            if (last && has_next) S.a_ready(nxt);
            if constexpr (SP2) {
            PG8_LDB(B0, 0, 0); PG8_LDB(B1, 0, 1); PG8_SCHED; PG8_LDA(At, 0, 0); PG8_STAGE(PG8_SA(1, 1), a1 + hstep, voffA);
            PG8_WAIT_V(8); PG8_WAIT_L(0); PG8_BAR; PG8_MMA(0, 0, At, B0); PG8_MMA(0, 1, At, B1); PG8_BAR; PG8_SCHED;
            PG8_LDA(At, 0, 1); PG8_STAGE(PG8_SB(0, 0), b2, voffB); PG8_STAGE(PG8_SB(0, 1), b2 + hstep, voffB); PG8_STAGE(PG8_SA(0, 0), a2, voffA);
            PG8_WAIT_V(8); PG8_WAIT_L(0); PG8_BAR; PG8_MMA(1, 0, At, B0); PG8_MMA(1, 1, At, B1); PG8_BAR; PG8_SCHED;
            PG8_LDB(B0, 1, 0); PG8_LDB(B1, 1, 1); PG8_SCHED; PG8_LDA(At, 1, 0); PG8_STAGE(PG8_SA(0, 1), a2 + hstep, voffA);
            PG8_WAIT_V(8); PG8_WAIT_L(0); PG8_BAR; PG8_MMA(0, 0, At, B0); PG8_MMA(0, 1, At, B1); PG8_BAR; PG8_SCHED;
            PG8_LDA(At, 1, 1); PG8_STAGE(PG8_SB(1, 0), b3, voffB); PG8_STAGE(PG8_SB(1, 1), b3 + hstep, voffB); PG8_STAGE(PG8_SA(1, 0), a3, voffA);
            PG8_WAIT_V(8); PG8_WAIT_L(0); PG8_BAR; PG8_MMA(1, 0, At, B0); PG8_MMA(1, 1, At, B1); PG8_BAR; PG8_SCHED;
            } else {
            PG8_LDB(B0, 0, 0); PG8_SCHED; PG8_LDA(At, 0, 0); PG8_STAGE(PG8_SA(1, 1), a1 + hstep, voffA);
            PG8_WAIT_L(8); PG8_BAR; PG8_WAIT_L(0); PG8_MMA(0, 0, At, B0); PG8_BAR; PG8_SCHED;
            PG8_LDB(B1, 0, 1); PG8_STAGE(PG8_SB(0, 0), b2, voffB);
            PG8_BAR; PG8_WAIT_L(0); PG8_MMA(0, 1, At, B1); PG8_BAR;
            PG8_LDA(At, 0, 1); PG8_STAGE(PG8_SA(0, 0), a2, voffA);
            PG8_BAR; PG8_WAIT_L(0); PG8_MMA(1, 0, At, B0); PG8_BAR; PG8_SCHED;
            PG8_STAGE(PG8_SB(0, 1), b2 + hstep, voffB);
            PG8_WAIT_V(6); PG8_BAR; PG8_MMA(1, 1, At, B1); PG8_BAR;
            PG8_LDB(B0, 1, 0); PG8_SCHED; PG8_LDA(At, 1, 0); PG8_STAGE(PG8_SA(0, 1), a2 + hstep, voffA);
            PG8_WAIT_L(8); PG8_BAR; PG8_WAIT_L(0); PG8_MMA(0, 0, At, B0); PG8_BAR; PG8_SCHED;
            PG8_LDB(B1, 1, 1); PG8_STAGE(PG8_SB(1, 0), b3, voffB);
            PG8_BAR; PG8_WAIT_L(0); PG8_MMA(0, 1, At, B1); PG8_BAR;
            PG8_LDA(At, 1, 1); PG8_STAGE(PG8_SA(1, 0), a3, voffA);
            PG8_BAR; PG8_WAIT_L(0); PG8_MMA(1, 0, At, B0); PG8_BAR; PG8_SCHED;
            PG8_STAGE(PG8_SB(1, 1), b3 + hstep, voffB);
            PG8_WAIT_V(6); PG8_BAR; PG8_MMA(1, 1, At, B1); PG8_BAR;
            }
        }
        if constexpr (ALIGN_EPI) { if (wr == 0) PG8_BAR; }
        if constexpr (!Epi::AFTER_DRAIN) { E(acc, cur, wr, wc, fr, fq, pre); S.done(cur); if (has_next) E.prefetch(pre, nxt, wr, fr, fq); }
        if (!has_next) break;
#pragma unroll
        for (int a = 0; a < 2; ++a)
#pragma unroll
            for (int b = 0; b < 2; ++b)
#pragma unroll
                for (int m = 0; m < 4; ++m)
#pragma unroll
                    for (int n = 0; n < 2; ++n) acc[a][b][m][n] = (f32x4){0.f, 0.f, 0.f, 0.f};
        cur = nxt; cA = nA; cB = nB; ++ui;
        if constexpr (ALIGN_EPI) { if (wr == 1) PG8_BAR; }
    }
    PG8_WAIT_V(0);
    if constexpr (!ALIGN_EPI) { if (wr == 0) PG8_BAR; }
    PG8_BAR;
    if constexpr (Epi::AFTER_DRAIN) { E.fused(acc, cur, wr, wc, fr, fq, lds, wid, lane); S.done(cur); }
#undef PG8_SA
#undef PG8_SB
#undef PG8_STAGE
#undef PG8_LDA
#undef PG8_LDB
#undef PG8_MMA
#undef PG8_WAIT_V
#undef PG8_WAIT_L
#undef PG8_BAR
#undef PG8_SCHED
}
}
#include <hip/hip_bf16.h>
#include <cmath>
namespace attn_body {
using bf16=__hip_bfloat16;
using bf16x8=__attribute__((ext_vector_type(8)))short;
using s16x4=__attribute__((ext_vector_type(4)))short;
using f32x16=__attribute__((ext_vector_type(16)))float;
using u32x4=__attribute__((ext_vector_type(4)))unsigned;
constexpr int BATCH=2,SEQ=8192,D=64;
constexpr int PQ=1024,PK=1536,PV=1536,PO=768;
constexpr int NW=8,QBLK=32,QB=QBLK*NW,KVBLK=64,NQB=SEQ/QB;
constexpr int ATTN_UNIT_ROWS=QB;
__device__ __forceinline__ int crow(int r,int hi){return (r&3)+8*(r>>2)+4*hi;}
#define SBAR() __builtin_amdgcn_sched_barrier(0)
__device__ __forceinline__ void cmask(f32x16&p0,f32x16&p1,int jb,int qrel,int hi){
  const float NEG=-INFINITY; int kb=64*jb+4*hi;
  #pragma unroll
  for(int r=0;r<16;++r){int kv=kb+(r&3)+8*(r>>2); if(kv>qrel)p0[r]=NEG; if(kv+32>qrel)p1[r]=NEG;}
}

constexpr int NSLOT=3, SLOTB=8192;
constexpr int LDS_K=0, LDS_V=NSLOT*SLOTB, LDS_WS=LDS_V+NSLOT*2*SLOTB, LDS_OST=LDS_WS+NW*64*4, LDS_BYTES=LDS_OST+NW*8192;
constexpr float C2=0.125f*1.4426950408889634f;
__device__ __forceinline__ void glds16(const void*gsrc,unsigned lds_dst){unsigned keep;
  asm volatile("s_mov_b32 %0, m0\n\ts_mov_b32 m0, %2\n\ts_nop 0\n\tglobal_load_lds_dwordx4 %1, off\n\ts_mov_b32 m0, %0":"=&s"(keep):"v"(gsrc),"s"(lds_dst):"memory");}
__device__ __forceinline__ float max3f(float a,float b,float c){float r;asm("v_max3_f32 %0, %1, %2, %3":"=v"(r):"v"(a),"v"(b),"v"(c));return r;}
__device__ __forceinline__ float max2f(float a,float b){float r;asm("v_max_f32_e32 %0, %1, %2":"=v"(r):"v"(a),"v"(b));return r;}
__device__ __forceinline__ float fadd_s(float a,float b){float r;asm("v_add_f32_e32 %0, %1, %2":"=v"(r):"v"(a),"v"(b));return r;}
__device__ __forceinline__ float fsub_s(float a,float b){float r;asm("v_sub_f32_e32 %0, %1, %2":"=v"(r):"v"(a),"v"(b));return r;}
typedef float f32x2_t __attribute__((ext_vector_type(2))); typedef __bf16 bf16x2_t __attribute__((ext_vector_type(2)));
__device__ __forceinline__ unsigned cvtpk_s(float lo,float hi){f32x2_t v={lo,hi};bf16x2_t b=__builtin_convertvector(v,bf16x2_t);return __builtin_bit_cast(unsigned,b);}
#define WAIT_BAR(N) asm volatile("s_waitcnt vmcnt(" #N ") lgkmcnt(0)\n\ts_barrier":::"memory")

__device__ __forceinline__ void qkt(f32x16&p0,f32x16&p1,const char*Kslot,const bf16x8*qr,int r32,int hi){
  const char*kb=Kslot+hi*1024+r32*16; const f32x16 z=f32x16{};
  #pragma unroll
  for(int d0=0;d0<4;++d0){
    const bf16x8 b0=*reinterpret_cast<const bf16x8*>(kb+d0*2048);
    const bf16x8 b1=*reinterpret_cast<const bf16x8*>(kb+d0*2048+512);
    if(d0==0){p0=__builtin_amdgcn_mfma_f32_32x32x16_bf16(b0,qr[0],z,0,0,0);p1=__builtin_amdgcn_mfma_f32_32x32x16_bf16(b1,qr[0],z,0,0,0);}
    else{p0=__builtin_amdgcn_mfma_f32_32x32x16_bf16(b0,qr[d0],p0,0,0,0);p1=__builtin_amdgcn_mfma_f32_32x32x16_bf16(b1,qr[d0],p1,0,0,0);}}
}
typedef __attribute__((address_space(3))) const char* lds_cptr;
typedef short v4i16_t __attribute__((ext_vector_type(4)));
__device__ __forceinline__ void kload8(bf16x8*kf,lds_cptr kp){
  kf[0]=*(const __attribute__((address_space(3))) bf16x8*)(kp);      kf[1]=*(const __attribute__((address_space(3))) bf16x8*)(kp+512);
  kf[2]=*(const __attribute__((address_space(3))) bf16x8*)(kp+2048); kf[3]=*(const __attribute__((address_space(3))) bf16x8*)(kp+2560);
  kf[4]=*(const __attribute__((address_space(3))) bf16x8*)(kp+4096); kf[5]=*(const __attribute__((address_space(3))) bf16x8*)(kp+4608);
  kf[6]=*(const __attribute__((address_space(3))) bf16x8*)(kp+6144); kf[7]=*(const __attribute__((address_space(3))) bf16x8*)(kp+6656);
}
__device__ __forceinline__ void kload2(bf16x8*kf,lds_cptr kp,int j){ kf[2*j]=*(const __attribute__((address_space(3))) bf16x8*)(kp+j*2048); kf[2*j+1]=*(const __attribute__((address_space(3))) bf16x8*)(kp+j*2048+512); }
__device__ __forceinline__ s16x4 vtr(lds_cptr p){ return __builtin_bit_cast(s16x4,__builtin_amdgcn_ds_read_tr16_b64_v4i16((__attribute__((address_space(3))) v4i16_t*)p)); }
__device__ __forceinline__ float rowmax(const f32x16&p0,const f32x16&p1){
  float a=max3f(p0[0],p0[1],p1[0]),b=max3f(p0[2],p0[3],p1[1]);a=max3f(a,p1[2],p1[3]);
  #pragma unroll
  for(int r=4;r<16;r+=4){a=max3f(a,p0[r],p0[r+1]);b=max3f(b,p0[r+2],p0[r+3]);a=max3f(a,p1[r],p1[r+1]);b=max3f(b,p1[r+2],p1[r+3]);}
  const float m=max2f(a,b);
  auto rr=__builtin_amdgcn_permlane32_swap(__float_as_uint(m),__float_as_uint(m),false,false);
  return max2f(__uint_as_float(rr[0]),__uint_as_float(rr[1]));
}
__device__ __forceinline__ void pv(f32x16*o,int vb,bf16x8 pa0,bf16x8 pa1,bf16x8 pa2,bf16x8 pa3){
  #pragma unroll
  for(int d0=0;d0<4;++d0){s16x4 lo[4],hi[4];
    #pragma unroll
    for(int ks=0;ks<4;++ks){
      asm volatile("ds_read_b64_tr_b16 %0,%1 offset:%c2":"=&v"(lo[ks]):"v"(vb),"i"(d0*4096+ks*1024):"memory");
      asm volatile("ds_read_b64_tr_b16 %0,%1 offset:%c2":"=&v"(hi[ks]):"v"(vb),"i"(d0*4096+ks*1024+512):"memory");}
    asm volatile("s_waitcnt lgkmcnt(0)":::"memory");SBAR();
    #define PK(k) (bf16x8){lo[k][0],lo[k][1],lo[k][2],lo[k][3],hi[k][0],hi[k][1],hi[k][2],hi[k][3]}
    o[d0]=__builtin_amdgcn_mfma_f32_32x32x16_bf16(pa0,PK(0),o[d0],0,0,0);
    o[d0]=__builtin_amdgcn_mfma_f32_32x32x16_bf16(pa1,PK(1),o[d0],0,0,0);
    o[d0]=__builtin_amdgcn_mfma_f32_32x32x16_bf16(pa2,PK(2),o[d0],0,0,0);
    o[d0]=__builtin_amdgcn_mfma_f32_32x32x16_bf16(pa3,PK(3),o[d0],0,0,0);
    #undef PK
  }
}

#ifndef ATTN_STORE16
#define ATTN_STORE16(p,v) asm volatile("global_store_dwordx4 %0, %1, off sc1\n\ts_nop 1"::"v"(p),"v"(v):"memory")
#endif
template<int THRL,bool FAST> __device__ __forceinline__ bool attn_unit(int qb,const bf16*Qb,const bf16*__restrict__ Kb,const bf16*__restrict__ Vb,bf16*Ob,char*shm){
  int tid_=threadIdx.x; asm volatile("":"+v"(tid_)); const int tid=tid_,lane=tid&63,r32=lane&31,hi=lane>>5; const int wid=__builtin_amdgcn_readfirstlane(tid>>6);
  const int q0=qb*QB;
  const bf16*Qw=Qb+(long)(q0+wid*QBLK)*PQ;
  const bf16*Kh=Kb,*Vh=Vb;
  const unsigned lds0=(unsigned)(uintptr_t)shm;
  float*wsf=(float*)(shm+LDS_WS)+wid*64;
  const bf16*ksrc=Kh+(long)lane*PK+wid*8;
  const bf16*vsrc=Vh+(long)(16*(wid&3)+(lane>>2))*PV+(wid>>2)*32+(lane&3)*8;
  const unsigned kdst=lds0+LDS_K+wid*1024, vdst=lds0+LDS_V+wid*1024;
  #define DMA_K(t,slot) glds16(ksrc+(long)(t)*KVBLK*PK,(unsigned)__builtin_amdgcn_readfirstlane(kdst+(slot)))
  #define DMA_V(t,slot) do{ glds16(vsrc+(long)(t)*KVBLK*PV,(unsigned)__builtin_amdgcn_readfirstlane(vdst+2*(slot))); glds16(vsrc+64+(long)(t)*KVBLK*PV,(unsigned)__builtin_amdgcn_readfirstlane(vdst+2*(slot)+8192)); }while(0)
  const int vb0=(int)(lds0+LDS_V)+((lane>>4)&1)*32+(lane&3)*8+(4*hi+((lane&15)>>2))*64;
  const char*Kbase=shm+LDS_K; bf16x8 kf[8];
  const lds_cptr shm3=(lds_cptr)shm; const lds_cptr kp0=shm3+LDS_K+hi*1024+r32*16; const lds_cptr vp0=shm3+LDS_V+((lane>>4)&1)*32+(lane&3)*8+(4*hi+((lane&15)>>2))*64;
  const int NT=(q0+QB)/KVBLK;
  DMA_K(0,0);DMA_V(0,0);DMA_K(1,SLOTB);
  bf16x8 qr[4];
  #pragma unroll
  for(int d0=0;d0<4;++d0)qr[d0]=*reinterpret_cast<const bf16x8*>(&Qw[(long)r32*PQ+d0*16+hi*8]);
  float mhat=0.f,l_reg=0.f;f32x16 o[4];o[0]=f32x16{};o[1]=f32x16{};o[2]=f32x16{};o[3]=f32x16{};
  const int qrel=wid*QBLK+r32;
  #define CMASK(P0,P1,t) do{int jb_=(t)-(NT-4); if(jb_>=0)cmask(P0,P1,jb_,qrel,hi);}while(0)
  bool resc=false;
  #define START(P0,P1) do{ if constexpr(FAST){ _Pragma("unroll") for(int r=0;r<16;++r){P0[r]=__builtin_amdgcn_exp2f(P0[r]);P1[r]=__builtin_amdgcn_exp2f(P1[r]);} } else { const float rm=rowmax(P0,P1); resc=false; mhat=rm; \
    _Pragma("unroll") for(int r=0;r<16;++r){P0[r]=__builtin_amdgcn_exp2f(fsub_s(P0[r],rm));P1[r]=__builtin_amdgcn_exp2f(fsub_s(P1[r],rm));} } }while(0)
  #define RESC() do{ if(!FAST && resc){ asm volatile("s_waitcnt lgkmcnt(0)":::"memory"); \
      _Pragma("unroll") for(int d_=0;d_<4;++d_) _Pragma("unroll") for(int r=0;r<16;++r)o[d_][r]*=wsf[crow(r,hi)]; } }while(0)
  f32x16 pA0,pA1,pB0,pB1;
  int sl_prev=0,sl_cur=0,sl_next=SLOTB;
  #define ROT() do{sl_prev=sl_cur;sl_cur=sl_next;sl_next=(sl_next==(NSLOT-1)*SLOTB)?0:sl_next+SLOTB;}while(0)
  DMA_K(2,2*SLOTB);
  WAIT_BAR(4);
  qkt(pA0,pA1,Kbase,qr,r32,hi);asm volatile("s_nop 15\n\ts_nop 7":"+v"(pA0),"+v"(pA1));CMASK(pA0,pA1,0);
  START(pA0,pA1);
  WAIT_BAR(0);
  DMA_K(3,0);DMA_V(1,SLOTB);
  ROT();
  kload8(kf,kp0+sl_cur);
  WAIT_BAR(3);
  s16x4 vlo[4],vhi[4]; u32x4 pw0,pw1,pw2,pw3;
  #define PKW(P,B) cvtpk_s(P[B],P[B+1])
  #define PAF(k) __builtin_bit_cast(bf16x8,pw##k)
  #define VFR(i) (bf16x8){vlo[i][0],vlo[i][1],vlo[i][2],vlo[i][3],vhi[i][0],vhi[i][1],vhi[i][2],vhi[i][3]}
  #define PIN(x) asm volatile("":"+v"(x))
  #define MX3(a,b,c) __builtin_fmaxf(__builtin_fmaxf((a),(b)),(c))
  #define GAPA(MF,A0,A1,A2,A3,W0,W1,PW) do{ MF; sacc+=A0; sacc+=A1; sacc+=A2; sacc+=A3; PIN(sacc); W0; W1; PIN(PW); SBAR(); }while(0)
  #define EX(v) __builtin_amdgcn_exp2f(v)
  #define VOFF(m) (((((m)&1)+2*((m)>>3))*4096)+((((m)>>1)&3)*1024))
  #define VRD(m) do{ vlo[(m)&3]=vtr(vp_+VOFF(m)); vhi[(m)&3]=vtr(vp_+VOFF(m)+512); }while(0)
  #define GAPB(MF,RD,X,B) do{ MF; RD; if constexpr(FAST){ X[B]=EX(X[B]); X[B+1]=EX(X[B+1]); } else { X[B]=EX(X[B]-mhat); X[B+1]=EX(X[B+1]-mhat); } PIN(X); SBAR(); }while(0)
  #define NORD do{}while(0)
  #define KRD(G,j) do{ if(G){ kload2(kf,kp0+sl_next,j); SBAR(); } }while(0)
  #define PVM(db,k,f) o[db]=__builtin_amdgcn_mfma_f32_32x32x16_bf16(PAF(k),VFR(f),o[db],0,0,0)
  #define STEP(C0,C1,P0,P1,t,GK,GV,GL) do{ SBAR(); \
    const lds_cptr vp_=vp0+2*sl_prev; const f32x16 z_=f32x16{}; \
    float sacc=(P0[0]+P0[1]); \
    GAPA(C0=__builtin_amdgcn_mfma_f32_32x32x16_bf16(kf[0],qr[0],z_,0,0,0), P0[2],P0[3],P0[4],P0[5],     pw0[0]=PKW(P0,0), pw0[1]=PKW(P0,2), pw0); \
    GAPA(C1=__builtin_amdgcn_mfma_f32_32x32x16_bf16(kf[1],qr[0],z_,0,0,0), P0[6],P0[7],P0[8],P0[9],     pw0[2]=PKW(P0,4), pw0[3]=PKW(P0,6), pw0); \
    GAPA(C0=__builtin_amdgcn_mfma_f32_32x32x16_bf16(kf[2],qr[1],C0,0,0,0),   P0[10],P0[11],P0[12],P0[13], pw1[0]=PKW(P0,8), pw1[1]=PKW(P0,10), pw1); \
    GAPA(C1=__builtin_amdgcn_mfma_f32_32x32x16_bf16(kf[3],qr[1],C1,0,0,0),   P0[14],P0[15],P1[0],P1[1],   pw1[2]=PKW(P0,12),pw1[3]=PKW(P0,14), pw1); \
    VRD(0); SBAR(); GAPA(C0=__builtin_amdgcn_mfma_f32_32x32x16_bf16(kf[4],qr[2],C0,0,0,0),   P1[2],P1[3],P1[4],P1[5],     pw2[0]=PKW(P1,0), pw2[1]=PKW(P1,2), pw2); \
    VRD(1); SBAR(); GAPA(C1=__builtin_amdgcn_mfma_f32_32x32x16_bf16(kf[5],qr[2],C1,0,0,0),   P1[6],P1[7],P1[8],P1[9],     pw2[2]=PKW(P1,4), pw2[3]=PKW(P1,6), pw2); \
    VRD(2); SBAR(); GAPA(C0=__builtin_amdgcn_mfma_f32_32x32x16_bf16(kf[6],qr[3],C0,0,0,0),   P1[10],P1[11],P1[12],P1[13], pw3[0]=PKW(P1,8), pw3[1]=PKW(P1,10), pw3); \
    VRD(3); SBAR(); GAPA(C1=__builtin_amdgcn_mfma_f32_32x32x16_bf16(kf[7],qr[3],C1,0,0,0),   P1[14],P1[15],0.f,0.f,       pw3[2]=PKW(P1,12),pw3[3]=PKW(P1,14), pw3); \
    l_reg+=sacc; \
    if(GK){DMA_K((t)+3,sl_cur);} if(GV){DMA_V((t)+1,sl_next);} \
    CMASK(C0,C1,t); \
        if constexpr(!FAST) { float a=MX3(C0[0],C0[1],C1[0]),b=MX3(C0[2],C0[3],C1[1]); a=MX3(a,C1[2],C1[3]); \
      _Pragma("unroll") for(int r=4;r<16;r+=4){a=MX3(a,C0[r],C0[r+1]);b=MX3(b,C0[r+2],C0[r+3]);a=MX3(a,C1[r],C1[r+1]);b=MX3(b,C1[r+2],C1[r+3]);} \
      float rm=__builtin_fmaxf(a,b); { auto rr=__builtin_amdgcn_permlane32_swap(__float_as_uint(rm),__float_as_uint(rm),false,false); rm=__builtin_fmaxf(__uint_as_float(rr[0]),__uint_as_float(rr[1])); } \
      resc=false; rm-=mhat; \
      if(__builtin_expect(__any(rm>(float)THRL),0)){ const float dl=__builtin_fmaxf(rm,0.f); mhat+=dl; \
        const float f=__builtin_amdgcn_exp2f(-dl); l_reg*=f; if(hi==0)wsf[r32]=f; resc=true; } } \
    SBAR(); \
    GAPB(PVM(0,0,0), VRD(4), C0,0); \
    GAPB(PVM(1,0,1), VRD(5), C0,2); \
    GAPB(PVM(0,1,2), VRD(6), C0,4); \
    GAPB(PVM(1,1,3), VRD(7), C0,6); \
    KRD(GL,0); GAPB(PVM(0,2,0), VRD(8), C0,8); \
    GAPB(PVM(1,2,1), VRD(9), C0,10); \
    KRD(GL,1); GAPB(PVM(0,3,2), VRD(10), C0,12); \
    GAPB(PVM(1,3,3), VRD(11), C0,14); \
    KRD(GL,2); GAPB(PVM(2,0,0), VRD(12), C1,0); \
    GAPB(PVM(3,0,1), VRD(13), C1,2); \
    KRD(GL,3); GAPB(PVM(2,1,2), VRD(14), C1,4); \
    GAPB(PVM(3,1,3), VRD(15), C1,6); \
    GAPB(PVM(2,2,0), NORD, C1,8); \
    GAPB(PVM(3,2,1), NORD, C1,10); \
    GAPB(PVM(2,3,2), NORD, C1,12); \
    GAPB(PVM(3,3,3), NORD, C1,14); \
    }while(0)
  int t=1;
  #undef CMASK
  #define CMASK(P0,P1,t) do{}while(0)
  for(;t+5<NT;t+=2){
    STEP(pB0,pB1,pA0,pA1,t,true,true,true);     WAIT_BAR(3); RESC(); ROT();
    STEP(pA0,pA1,pB0,pB1,t+1,true,true,true);   WAIT_BAR(3); RESC(); ROT();
  }
  #undef CMASK
  #define CMASK(P0,P1,t) do{int jb_=(t)-(NT-4); if(jb_>=0)cmask(P0,P1,jb_,qrel,hi);}while(0)
  #define ENDW(tt) do{ if((tt)+3<NT){WAIT_BAR(3);} else if((tt)+2<NT){WAIT_BAR(2);} else {WAIT_BAR(0);} }while(0)
  for(;t+1<NT;t+=2){
    STEP(pB0,pB1,pA0,pA1,t,(t+3<NT),(t+1<NT),(t+1<NT));       ENDW(t);   RESC(); ROT();
    STEP(pA0,pA1,pB0,pB1,t+1,(t+4<NT),(t+2<NT),(t+2<NT));     ENDW(t+1); RESC(); ROT();
  }
  STEP(pB0,pB1,pA0,pA1,NT-1,false,false,false); RESC();
  { float sacc=pB0[0]+pB0[1]; _Pragma("unroll") for(int r=2;r<16;++r)sacc+=pB0[r]; _Pragma("unroll") for(int r=0;r<16;++r)sacc+=pB1[r]; l_reg+=sacc;
    pw0=(u32x4){PKW(pB0,0),PKW(pB0,2),PKW(pB0,4),PKW(pB0,6)};pw1=(u32x4){PKW(pB0,8),PKW(pB0,10),PKW(pB0,12),PKW(pB0,14)};pw2=(u32x4){PKW(pB1,0),PKW(pB1,2),PKW(pB1,4),PKW(pB1,6)};pw3=(u32x4){PKW(pB1,8),PKW(pB1,10),PKW(pB1,12),PKW(pB1,14)};
    SBAR(); pv(o,vb0+2*sl_cur,PAF(0),PAF(1),PAF(2),PAF(3)); }
  #undef PKW
  #undef PAF
  #undef VFR
  #undef PIN
  #undef MX3
  #undef GAPA
  #undef GAPB
  #undef NORD
  #undef PVM
  #undef VOFF
  #undef EX
  #undef VRD
  #undef KRD
  #undef STEP
  #undef ENDW
  {auto rr=__builtin_amdgcn_permlane32_swap(__float_as_uint(l_reg),__float_as_uint(l_reg),false,false);l_reg=__uint_as_float(rr[0])+__uint_as_float(rr[1]);}
  if(hi==0)wsf[32+r32]=l_reg;asm volatile("s_waitcnt lgkmcnt(0)":::"memory");
  float rli[16];
  #pragma unroll
  for(int r=0;r<16;++r)rli[r]=__builtin_amdgcn_rcpf(wsf[32+crow(r,hi)]);
  bf16*Ow=Ob+(long)(q0+wid*QBLK)*PO;
  { bf16*stg=(bf16*)(shm+LDS_OST)+wid*4096;
    #pragma unroll
    for(int r=0;r<16;++r){const int orow=crow(r,hi);
      #pragma unroll
      for(int d0=0;d0<4;++d0)stg[orow*128+d0*32+r32]=__float2bfloat16(o[d0][r]*rli[r]);}
    asm volatile("s_waitcnt lgkmcnt(0)":::"memory");
    #pragma unroll
    for(int i=0;i<8;++i){const int row=i*4+(lane>>4),ch=lane&15; const u32x4 v=*(const u32x4*)(stg+row*128+ch*8); ATTN_STORE16(Ow+(long)row*PO+ch*8,v);} }
  bool bad=false;
  if constexpr(FAST){ int* flg=(int*)(shm+LDS_WS); asm volatile("s_waitcnt lgkmcnt(0)\n\ts_barrier":::"memory");
    if(tid==0)flg[0]=0; asm volatile("s_waitcnt lgkmcnt(0)\n\ts_barrier":::"memory");
    if(__any(!(l_reg>0x1p-60f&&l_reg<0x1p60f))&&lane==0)flg[0]=1; asm volatile("s_waitcnt lgkmcnt(0)\n\ts_barrier":::"memory");
    bad=flg[0]!=0; }
  asm volatile("s_waitcnt lgkmcnt(0)\n\ts_barrier":::"memory");
  #undef DMA_K
  #undef DMA_V
  #undef CMASK
  #undef START
  #undef RESC
  #undef ROT
  return bad;
}
template<bool LATE> __device__ __forceinline__ bool attn_unit_fast(int qb,const bf16*Qb,const bf16*__restrict__ Kb,const bf16*__restrict__ Vb,bf16*Ob,char*shm,bool pre,const bf16*Kn,const bf16*Vn){
  int tid_=threadIdx.x; asm volatile("":"+v"(tid_)); const int tid=tid_,lane=tid&63,r32=lane&31,hi=lane>>5; const int wid=__builtin_amdgcn_readfirstlane(tid>>6);
  constexpr int FK=0, FV=4*SLOTB, FWS=FV+4*2*SLOTB;
  const int q0=qb*QB;
  const bf16*Qw=Qb+(long)(q0+wid*QBLK)*PQ;
  const unsigned lds0=(unsigned)(uintptr_t)shm;
  float*wsf=(float*)(shm+FWS)+wid*64;
  const bf16*ksrc=Kb+(long)lane*PK+wid*8;
  const bf16*vsrc=Vb+(long)(16*(wid&3)+(lane>>2))*PV+(wid>>2)*32+(lane&3)*8;
  const unsigned kdst=lds0+FK+wid*1024, vdst=lds0+FV+wid*1024;
  #define KSL(t) (((t)&3)*SLOTB)
  #define RFL(x) ((unsigned)__builtin_amdgcn_readfirstlane(x))
  #define DMA_K(t) glds16(ksrc+(long)(t)*KVBLK*PK,RFL(kdst+KSL(t)))
  #define DMA_V(t) do{ glds16(vsrc+(long)(t)*KVBLK*PV,RFL(vdst+2*KSL(t))); glds16(vsrc+64+(long)(t)*KVBLK*PV,RFL(vdst+2*KSL(t)+8192)); }while(0)
  const int vb0=(int)(lds0+FV)+((lane>>4)&1)*32+(lane&3)*8+(4*hi+((lane&15)>>2))*64;
  bf16x8 kf[8];
  const lds_cptr shm3=(lds_cptr)shm; const lds_cptr kp0=shm3+FK+hi*1024+r32*16; const lds_cptr vp0=shm3+FV+((lane>>4)&1)*32+(lane&3)*8+(4*hi+((lane&15)>>2))*64;
  const int NT=(q0+QB)/KVBLK;
  if(!pre){DMA_K(0);DMA_V(0);DMA_K(1);}
  bf16x8 qr[4];
  #pragma unroll
  for(int d0=0;d0<4;++d0)qr[d0]=*reinterpret_cast<const bf16x8*>(&Qw[(long)r32*PQ+d0*16+hi*8]);
  float l_reg=0.f;f32x16 o[4];o[0]=f32x16{};o[1]=f32x16{};o[2]=f32x16{};o[3]=f32x16{};
  const int qrel=wid*QBLK+r32;
  #define CMASK(P0,P1,t) do{int jb_=(t)-(NT-4); if(jb_>=0)cmask(P0,P1,jb_,qrel,hi);}while(0)
  f32x16 pA0,pA1,pB0,pB1;
  if(!pre)DMA_K(2);
  WAIT_BAR(4);
  qkt(pA0,pA1,shm+FK,qr,r32,hi);asm volatile("s_nop 15\n\ts_nop 7":"+v"(pA0),"+v"(pA1));CMASK(pA0,pA1,0);
  _Pragma("unroll") for(int r=0;r<16;++r){pA0[r]=__builtin_amdgcn_exp2f(pA0[r]);pA1[r]=__builtin_amdgcn_exp2f(pA1[r]);}
  WAIT_BAR(0);
  DMA_K(3);DMA_V(1);
  kload8(kf,kp0+KSL(1));
  WAIT_BAR(3);
  s16x4 vlo[4],vhi[4]; u32x4 pw0,pw1,pw2,pw3;
  #define PKW(P,B) cvtpk_s(P[B],P[B+1])
  #define PAF(k) __builtin_bit_cast(bf16x8,pw##k)
  #define VFR(i) (bf16x8){vlo[i][0],vlo[i][1],vlo[i][2],vlo[i][3],vhi[i][0],vhi[i][1],vhi[i][2],vhi[i][3]}
  #define PIN(x) asm volatile("":"+v"(x))
  #define GAPA(MF,A0,A1,A2,A3,W0,W1,PW) do{ MF; sacc+=A0; sacc+=A1; sacc+=A2; sacc+=A3; PIN(sacc); W0; W1; PIN(PW); SBAR(); }while(0)
  #define EX(v) __builtin_amdgcn_exp2f(v)
  #define VOFF(m) (((((m)&1)+2*((m)>>3))*4096)+((((m)>>1)&3)*1024))
  #define VRD(m) do{ vlo[(m)&3]=vtr(vp_+VOFF(m)); vhi[(m)&3]=vtr(vp_+VOFF(m)+512); }while(0)
  #define GAPB(MF,RD,X,B) do{ MF; RD; X[B]=EX(X[B]); X[B+1]=EX(X[B+1]); PIN(X); SBAR(); }while(0)
  #define NORD do{}while(0)
  #define KRD(G,j,t) do{ if(G){ kload2(kf,kp0+KSL((t)+1),j); SBAR(); } }while(0)
  #define PVM(db,k,f) o[db]=__builtin_amdgcn_mfma_f32_32x32x16_bf16(PAF(k),VFR(f),o[db],0,0,0)
  #define PHA(C0,C1,P0,P1,t) do{ SBAR(); \
    const lds_cptr vp_=vp0+2*KSL((t)-1); const f32x16 z_=f32x16{}; \
    float sacc=(P0[0]+P0[1]); \
    GAPA(C0=__builtin_amdgcn_mfma_f32_32x32x16_bf16(kf[0],qr[0],z_,0,0,0), P0[2],P0[3],P0[4],P0[5],     pw0[0]=PKW(P0,0), pw0[1]=PKW(P0,2), pw0); \
    GAPA(C1=__builtin_amdgcn_mfma_f32_32x32x16_bf16(kf[1],qr[0],z_,0,0,0), P0[6],P0[7],P0[8],P0[9],     pw0[2]=PKW(P0,4), pw0[3]=PKW(P0,6), pw0); \
    GAPA(C0=__builtin_amdgcn_mfma_f32_32x32x16_bf16(kf[2],qr[1],C0,0,0,0),   P0[10],P0[11],P0[12],P0[13], pw1[0]=PKW(P0,8), pw1[1]=PKW(P0,10), pw1); \
    GAPA(C1=__builtin_amdgcn_mfma_f32_32x32x16_bf16(kf[3],qr[1],C1,0,0,0),   P0[14],P0[15],P1[0],P1[1],   pw1[2]=PKW(P0,12),pw1[3]=PKW(P0,14), pw1); \
    VRD(0); SBAR(); GAPA(C0=__builtin_amdgcn_mfma_f32_32x32x16_bf16(kf[4],qr[2],C0,0,0,0),   P1[2],P1[3],P1[4],P1[5],     pw2[0]=PKW(P1,0), pw2[1]=PKW(P1,2), pw2); \
    VRD(1); SBAR(); GAPA(C1=__builtin_amdgcn_mfma_f32_32x32x16_bf16(kf[5],qr[2],C1,0,0,0),   P1[6],P1[7],P1[8],P1[9],     pw2[2]=PKW(P1,4), pw2[3]=PKW(P1,6), pw2); \
    VRD(2); SBAR(); GAPA(C0=__builtin_amdgcn_mfma_f32_32x32x16_bf16(kf[6],qr[3],C0,0,0,0),   P1[10],P1[11],P1[12],P1[13], pw3[0]=PKW(P1,8), pw3[1]=PKW(P1,10), pw3); \
    VRD(3); SBAR(); GAPA(C1=__builtin_amdgcn_mfma_f32_32x32x16_bf16(kf[7],qr[3],C1,0,0,0),   P1[14],P1[15],0.f,0.f,       pw3[2]=PKW(P1,12),pw3[3]=PKW(P1,14), pw3); \
    l_reg+=sacc; SBAR(); }while(0)
  #define DMAI(t,GK,GV) do{ if(GK){DMA_K((t)+3);} if(GV){DMA_V((t)+1);} }while(0)
  #define PHB(C0,C1,t,GL) do{ SBAR(); CMASKB(C0,C1,t); \
    const lds_cptr vp_=vp0+2*KSL((t)-1); \
    GAPB(PVM(0,0,0), VRD(4), C0,0); \
    GAPB(PVM(1,0,1), VRD(5), C0,2); \
    GAPB(PVM(0,1,2), VRD(6), C0,4); \
    GAPB(PVM(1,1,3), VRD(7), C0,6); \
    KRD(GL,0,t); GAPB(PVM(0,2,0), VRD(8), C0,8); \
    GAPB(PVM(1,2,1), VRD(9), C0,10); \
    KRD(GL,1,t); GAPB(PVM(0,3,2), VRD(10), C0,12); \
    GAPB(PVM(1,3,3), VRD(11), C0,14); \
    KRD(GL,2,t); GAPB(PVM(2,0,0), VRD(12), C1,0); \
    GAPB(PVM(3,0,1), VRD(13), C1,2); \
    KRD(GL,3,t); GAPB(PVM(2,1,2), VRD(14), C1,4); \
    GAPB(PVM(3,1,3), VRD(15), C1,6); \
    GAPB(PVM(2,2,0), NORD, C1,8); \
    GAPB(PVM(3,2,1), NORD, C1,10); \
    GAPB(PVM(2,3,2), NORD, C1,12); \
    GAPB(PVM(3,3,3), NORD, C1,14); \
    }while(0)
  #define ENDW(tt) do{ if((tt)+3<NT){WAIT_BAR(3);} else if((tt)+2<NT){WAIT_BAR(2);} else {WAIT_BAR(0);} }while(0)
  if constexpr(!LATE){
    int t=1;
    #define CMASKB(P0,P1,t) do{}while(0)
    for(;t+5<NT;t+=2){
      PHA(pB0,pB1,pA0,pA1,t);   DMAI(t,true,true);   PHB(pB0,pB1,t,true);   WAIT_BAR(3);
      PHA(pA0,pA1,pB0,pB1,t+1); DMAI(t+1,true,true); PHB(pA0,pA1,t+1,true); WAIT_BAR(3);
    }
    #undef CMASKB
    #define CMASKB(P0,P1,t) CMASK(P0,P1,t)
    for(;t+1<NT;t+=2){
      PHA(pB0,pB1,pA0,pA1,t);   DMAI(t,(t+3<NT),(t+1<NT));   PHB(pB0,pB1,t,(t+1<NT));   ENDW(t);
      PHA(pA0,pA1,pB0,pB1,t+1); DMAI(t+1,(t+4<NT),(t+2<NT)); PHB(pA0,pA1,t+1,(t+2<NT)); ENDW(t+1);
    }
    PHA(pB0,pB1,pA0,pA1,NT-1); PHB(pB0,pB1,NT-1,false);
    #undef CMASKB
  } else {
    DMAI(1,(4<NT),(2<NT)); PHA(pB0,pB1,pA0,pA1,1); ENDW(1);
    int t=2;
    #define CMASKB(P0,P1,t) do{}while(0)
    for(;t+4<NT;t+=2){
      PHB(pB0,pB1,t-1,true); DMAI(t,true,true);   PHA(pA0,pA1,pB0,pB1,t);   WAIT_BAR(3);
      PHB(pA0,pA1,t,true);   DMAI(t+1,true,true); PHA(pB0,pB1,pA0,pA1,t+1); WAIT_BAR(3);
    }
    #undef CMASKB
    #define CMASKB(P0,P1,t) CMASK(P0,P1,t)
    for(;t+1<NT;t+=2){
      PHB(pB0,pB1,t-1,true);     DMAI(t,(t+3<NT),(t+1<NT));   PHA(pA0,pA1,pB0,pB1,t);   ENDW(t);
      PHB(pA0,pA1,t,(t+1<NT));   DMAI(t+1,(t+4<NT),(t+2<NT)); PHA(pB0,pB1,pA0,pA1,t+1); if(t+2<NT){ENDW(t+1);}
    }
    PHB(pB0,pB1,NT-1,false);
    #undef CMASKB
  }
  { float sacc=pB0[0]+pB0[1]; _Pragma("unroll") for(int r=2;r<16;++r)sacc+=pB0[r]; _Pragma("unroll") for(int r=0;r<16;++r)sacc+=pB1[r]; l_reg+=sacc;
    pw0=(u32x4){PKW(pB0,0),PKW(pB0,2),PKW(pB0,4),PKW(pB0,6)};pw1=(u32x4){PKW(pB0,8),PKW(pB0,10),PKW(pB0,12),PKW(pB0,14)};pw2=(u32x4){PKW(pB1,0),PKW(pB1,2),PKW(pB1,4),PKW(pB1,6)};pw3=(u32x4){PKW(pB1,8),PKW(pB1,10),PKW(pB1,12),PKW(pB1,14)};
    SBAR(); pv(o,vb0+2*KSL(NT-1),PAF(0),PAF(1),PAF(2),PAF(3)); }
  #undef PKW
  #undef PAF
  #undef VFR
  #undef PIN
  #undef GAPA
  #undef GAPB
  #undef NORD
  #undef PVM
  #undef VOFF
  #undef EX
  #undef VRD
  #undef KRD
  #undef PHA
  #undef PHB
  #undef DMAI
  #undef ENDW
  asm volatile("s_waitcnt lgkmcnt(0)\n\ts_barrier":::"memory");
  if(Kn){ const bf16*kn=Kn+(long)lane*PK+wid*8; const bf16*vn=Vn+(long)(16*(wid&3)+(lane>>2))*PV+(wid>>2)*32+(lane&3)*8;
    glds16(kn,RFL(kdst+KSL(0))); glds16(vn,RFL(vdst+2*KSL(0))); glds16(vn+64,RFL(vdst+2*KSL(0)+8192)); glds16(kn+(long)KVBLK*PK,RFL(kdst+KSL(1))); glds16(kn+(long)2*KVBLK*PK,RFL(kdst+KSL(2))); }
  {auto rr=__builtin_amdgcn_permlane32_swap(__float_as_uint(l_reg),__float_as_uint(l_reg),false,false);l_reg=__uint_as_float(rr[0])+__uint_as_float(rr[1]);}
  if(hi==0)wsf[32+r32]=l_reg;asm volatile("s_waitcnt lgkmcnt(0)":::"memory");
  float rli[16];
  #pragma unroll
  for(int r=0;r<16;++r)rli[r]=__builtin_amdgcn_rcpf(wsf[32+crow(r,hi)]);
  bf16*Ow=Ob+(long)(q0+wid*QBLK)*PO;
  { bf16*stg=(bf16*)(shm+(wid<5?FWS+2048+wid*8192:wid<7?FV+2*SLOTB+(wid-5)*8192:FV+4*SLOTB));
    #pragma unroll
    for(int r=0;r<16;++r){const int orow=crow(r,hi);
      #pragma unroll
      for(int d0=0;d0<4;++d0)stg[orow*128+d0*32+r32]=__float2bfloat16(o[d0][r]*rli[r]);}
    asm volatile("s_waitcnt lgkmcnt(0)":::"memory");
    #pragma unroll
    for(int i=0;i<8;++i){const int row=i*4+(lane>>4),ch=lane&15; const u32x4 v=*(const u32x4*)(stg+row*128+ch*8); ATTN_STORE16(Ow+(long)row*PO+ch*8,v);} }
  bool bad=false;
  { int* flg=(int*)(shm+FWS); asm volatile("s_waitcnt lgkmcnt(0)\n\ts_barrier":::"memory");
    if(tid==0)flg[0]=0; asm volatile("s_waitcnt lgkmcnt(0)\n\ts_barrier":::"memory");
    if(__any(!(l_reg>0x1p-60f&&l_reg<0x1p60f))&&lane==0)flg[0]=1; asm volatile("s_waitcnt lgkmcnt(0)\n\ts_barrier":::"memory");
    bad=flg[0]!=0; }
  asm volatile("s_waitcnt lgkmcnt(0)\n\ts_barrier":::"memory");
  #undef DMA_K
  #undef DMA_V
  #undef KSL
  #undef RFL
  #undef CMASK
  return bad;
}
constexpr int ATTN_LDS_BYTES=LDS_BYTES;
template<int THRL=8> __device__ __forceinline__ void attn_phase(char*lds,const bf16*Q,const bf16*K,const bf16*V,bf16*O,int vcu,int G){
  const int nun=(G==256)?3:(24*32+G-1)/G; bool pre=false;
  for(int i=0;i<nun;++i){
    int vh,qb;
    if(G==256){ const int x=vcu>>5,j=vcu&31; vh=3*x+i; qb=(i==0)?j:(i==1)?((j<16)?j+16:j-16):((j<16)?31-2*j:62-2*j); }
    else { const int u=vcu+i*G; if(u>=24*32)break; vh=u>>5; qb=u&31; }
    const int b=vh/12,r=vh%12,h=r>>1,c=r&1;
    const long rb=(long)b*SEQ;
    const bool late=__builtin_amdgcn_readfirstlane((int)(threadIdx.x>>8))!=0;
    const bf16*Qp=Q+rb*PQ+h*128+c*64,*Kp=K+rb*PK+h*128+c*64,*Vp=V+rb*PV+h*128; bf16*Op=O+((long)c*BATCH*SEQ+rb)*PO+h*128;
    const bf16*Kn=nullptr,*Vn=nullptr;
    if(i+1<nun){ int vh2=-1; if(G==256) vh2=3*(vcu>>5)+i+1; else { const int u2=vcu+(i+1)*G; if(u2<24*32) vh2=u2>>5; }
      if(vh2>=0){ const int b2=vh2/12,r2=vh2%12,h2=r2>>1,c2=r2&1; Kn=K+(long)b2*SEQ*PK+h2*128+c2*64; Vn=V+(long)b2*SEQ*PV+h2*128; } }
    bool bad; if(late) bad=attn_unit_fast<true>(qb,Qp,Kp,Vp,Op,lds,pre,Kn,Vn); else bad=attn_unit_fast<false>(qb,Qp,Kp,Vp,Op,lds,pre,Kn,Vn);
    pre=(Kn!=nullptr)&&!bad;
    if(bad){ asm volatile("s_waitcnt vmcnt(0)\n\ts_barrier":::"memory");
      attn_unit<THRL,false>(qb,Q+rb*PQ+h*128+c*64,K+rb*PK+h*128+c*64,V+rb*PV+h*128,O+((long)c*BATCH*SEQ+rb)*PO+h*128,lds); }
  }
}
#undef SBAR
#undef WAIT_BAR
}
#include <hip/hip_cooperative_groups.h>
namespace cg = cooperative_groups;
#define GAS __attribute__((address_space(1)))
#define LAS __attribute__((address_space(3)))
typedef unsigned short bf16;
typedef unsigned v4u __attribute__((ext_vector_type(4)));
typedef unsigned v2u __attribute__((ext_vector_type(2)));
typedef float f32x4 __attribute__((ext_vector_type(4)));
typedef float f32x16 __attribute__((ext_vector_type(16)));
typedef short bf16x8 __attribute__((ext_vector_type(8)));
typedef short s16x4 __attribute__((ext_vector_type(4)));
#define LDS_WAIT() asm volatile("s_waitcnt lgkmcnt(0)" ::: "memory")

constexpr int NWAVES = 8, NTHR = 512;
constexpr int BATCH = 2, SEQ = 8192, T = BATCH * SEQ, D = 1024, FF = 2816, MIX = 768, NMEM = 256;
constexpr int PROJW = 3 * MIX + 256;
constexpr int PROJS = 2 * MIX + 256;
constexpr float EPS = 1e-6f;
constexpr float LAM_INIT = 0.35550906759096934f;
constexpr float C2 = 0.125f * 1.4426950408889634f;
constexpr size_t MiB = 1u << 20;
constexpr size_t WS_CTL = 0, WS_SSQ = 1 * MiB, WS_CS = 2 * MiB, WS_MEMB = 3 * MiB, WS_MEMKV = 4 * MiB, WS_SSQM = 5 * MiB, WS_W = 6 * MiB, WS_HB = 88 * MiB, WS_ACT = 120 * MiB, WS_KV = 208 * MiB, WS_END = 256 * MiB;
constexpr size_t WS_OB = 152 * MiB;
constexpr size_t W1_SZ = (size_t)2 * FF * D, W2_SZ = (size_t)D * FF;
constexpr size_t WO_W1_0 = 0, WO_W1_1 = W1_SZ, WO_KV = 2 * W1_SZ, WO_W1_2 = WO_KV + (size_t)1536 * D, WO_W1_3 = WO_W1_2 + W1_SZ, WO_W2 = WO_W1_3 + W1_SZ,
                 WO_AIN = WO_W2 + 4 * W2_SZ, WO_AOUT = WO_AIN + (size_t)PROJW * D, WO_Q = WO_AOUT + (size_t)D * D, WO_BOUT = WO_Q + (size_t)D * D, WO_MKV = WO_BOUT + (size_t)D * D, WO_END = WO_MKV + (size_t)2 * 512 * D;
static_assert(WO_END * 2 == 82 * MiB, "weights fill [6, 88) MiB");
constexpr int LDS_BYTES = 147456;

enum { K_PREP = 0, K_SWIGLU = 1, K_RES = 2, K_SCALE = 3, K_ROPE = 4, K_MIXA = 5, K_ATTN = 6, K_COMB = 7, K_FINAL = 8 };
struct Step { int kind, sync_after, M, N, K, ldc; float scale; int pad; int coff, tskip; const void* A; const void* Bt; void* p0; void* p1; void* p2; void* p3; };
constexpr int MAX_STEPS = 40;
struct Args { Step steps[MAX_STEPS]; const void* in[22]; float* out; unsigned char* ws; int lo, hi; };

__device__ __forceinline__ float bf_lo(unsigned w) { return __builtin_bit_cast(float, w << 16); }
__device__ __forceinline__ float bf_hi(unsigned w) { return __builtin_bit_cast(float, w & 0xffff0000u); }
__device__ __forceinline__ unsigned pk2(float lo, float hi) { return pg8::cvt_pk_bf16(lo, hi); }
__device__ __forceinline__ void st16_wt(void* p, const v4u v) { asm volatile("global_store_dwordx4 %0, %1, off sc1\n\ts_nop 1" :: "v"(p), "v"(v) : "memory"); }
__device__ __forceinline__ float wave_sum(float v) {
#pragma unroll
    for (int o = 1; o < 64; o <<= 1) v += __shfl_xor(v, o);
    return v;
}

struct WJob { const float* W; const float* gain; bf16* Wt; int K, N, mode; };
__device__ __forceinline__ void transpose_item(const WJob& J, LAS float* scr, int item, int lane) {
    const int nblk = J.N / 32, kb = item / nblk, nb = item % nblk, k0 = 64 * kb, n0d = 32 * nb;
    int n0s = n0d; bool perm = false;
    if (J.mode == 1) { const int pn = n0d >> 8, j = n0d & 255; n0s = (j < 128) ? (128 * pn + j) : (FF + 128 * pn + (j - 128)); }
    if (J.mode == 2) perm = (n0d < MIX) && ((n0d & 63) == 0);
    if (J.mode == 3 && n0d >= MIX && n0d < 3 * MIX) { const int pn = (n0d - MIX) >> 8, j = (n0d - MIX) & 255; n0s = (j < 128) ? (MIX + 128 * pn + j) : (2 * MIX + 128 * pn + (j - 128)); }
    const int c = lane & 7;
    f32x4 g0 = (f32x4){1.f, 1.f, 1.f, 1.f}, g1 = g0;
    if (J.gain) { g0 = *(const f32x4*)(J.gain + k0 + 8 * c); g1 = *(const f32x4*)(J.gain + k0 + 8 * c + 4); }
    const float* src = J.W + (size_t)(k0 + (lane >> 5)) * J.N + n0s + (lane & 31);
    float v[32];
#pragma unroll
    for (int i = 0; i < 32; ++i) v[i] = __builtin_nontemporal_load(src + (size_t)(2 * i) * J.N);
#pragma unroll
    for (int i = 0; i < 32; ++i) scr[(2 * i + (lane >> 5)) * 33 + (lane & 31)] = v[i];
    LDS_WAIT(); asm volatile("" ::: "memory");
#pragma unroll
    for (int j = 0; j < 4; ++j) { const int n = (lane >> 3) + 8 * j; const int ns = (perm && n < 16) ? ((n & 1) ? 8 + (n >> 1) : (n >> 1)) : n;
        const LAS float* s = scr + (8 * c) * 33 + ns;
        v4u o; o.x = pk2(s[0 * 33] * g0[0], s[1 * 33] * g0[1]); o.y = pk2(s[2 * 33] * g0[2], s[3 * 33] * g0[3]); o.z = pk2(s[4 * 33] * g1[0], s[5 * 33] * g1[1]); o.w = pk2(s[6 * 33] * g1[2], s[7 * 33] * g1[3]);
        st16_wt(J.Wt + (size_t)(n0d + n) * J.K + k0 + 8 * c, o); }
    LDS_WAIT(); asm volatile("" ::: "memory");
}
__device__ __forceinline__ void row_to_bf16(const float* xrow, bf16* orow, float* ssqrow, int lane) {
    const f32x4* xr = (const f32x4*)xrow + 2 * lane; f32x4 v[4]; float s = 0.f;
#pragma unroll
    for (int j = 0; j < 4; ++j) { v[j] = __builtin_nontemporal_load(xr + (j & 1) + 128 * (j >> 1)); s += (v[j][0] * v[j][0] + v[j][1] * v[j][1]) + (v[j][2] * v[j][2] + v[j][3] * v[j][3]); }
    s = wave_sum(s);
#pragma unroll
    for (int h = 0; h < 2; ++h) { v4u w; w.x = pk2(v[2 * h][0], v[2 * h][1]); w.y = pk2(v[2 * h][2], v[2 * h][3]); w.z = pk2(v[2 * h + 1][0], v[2 * h + 1][1]); w.w = pk2(v[2 * h + 1][2], v[2 * h + 1][3]);
        st16_wt(orow + 8 * lane + 512 * h, w); }
    if (lane < 4) __hip_atomic_store(ssqrow + lane, (lane == 0) ? s : 0.f, __ATOMIC_RELAXED, __HIP_MEMORY_SCOPE_AGENT);
}
typedef const __attribute__((address_space(4))) Args* ArgsP;
constexpr int I_W1 = (D / 64) * (2 * FF / 32), I_W2 = (FF / 64) * (D / 32), I_AIN = (D / 64) * (PROJW / 32), I_SQ = (D / 64) * (D / 32), I_KV = (D / 64) * (1536 / 32), I_MKV = (D / 64) * (512 / 32);
__device__ __forceinline__ int job_items(int j) { return j < 4 ? I_W1 : j < 8 ? I_W2 : j == 8 ? I_AIN : j == 10 ? I_KV : j < 13 ? I_SQ : j < 15 ? I_MKV : 0; }
__device__ __forceinline__ void convert_chunk(ArgsP ap, LAS float* scr, int gw, int NGW, int lane, int chunk) {
    typedef const float* cfp_t; const __attribute__((address_space(4))) cfp_t* in = (const __attribute__((address_space(4))) cfp_t*)ap->in;
    bf16* WB = (bf16*)(ap->ws + WS_W);
    const unsigned packed = chunk == 0 ? 0xED40u : chunk == 1 ? 0xA198u : chunk == 2 ? 0xCB25u : 0xF736u;
    const int j0 = packed & 15, j1 = (packed >> 4) & 15, j2 = (packed >> 8) & 15, j3 = (packed >> 12) & 15;
    const int n0 = job_items(j0), n1 = job_items(j1), n2 = job_items(j2), n3 = job_items(j3), total = n0 + n1 + n2 + n3;
    for (int it = gw; it < total; it += NGW) {
        int r = it, j = j0;
        if (r >= n0) { r -= n0; j = j1; if (r >= n1) { r -= n1; j = j2; if (r >= n2) { r -= n2; j = j3; } } }
        WJob J;
        if (j < 4) { const int l = j >> 1, post = j & 1;
            J.W = in[post ? 19 : 4] + (size_t)l * D * 2 * FF; J.gain = in[post ? 18 : 3] + l * D; J.Wt = WB + (j == 0 ? WO_W1_0 : j == 1 ? WO_W1_1 : j == 2 ? WO_W1_2 : WO_W1_3); J.K = D; J.N = 2 * FF; J.mode = 1; }
        else if (j < 8) { const int i = j - 4, l = i >> 1, post = i & 1;
            J.W = in[post ? 20 : 5] + (size_t)l * FF * D; J.gain = nullptr; J.Wt = WB + WO_W2 + (size_t)i * W2_SZ; J.K = FF; J.N = D; J.mode = 0; }
        else if (j == 8) { J.W = in[9]; J.gain = in[6]; J.Wt = WB + WO_AIN; J.K = D; J.N = PROJW; J.mode = 3; }
        else if (j == 9) { J.W = in[11]; J.gain = nullptr; J.Wt = WB + WO_AOUT; J.K = D; J.N = D; J.mode = 0; }
        else if (j == 10) { J.W = in[13]; J.gain = in[12]; J.Wt = WB + WO_KV; J.K = D; J.N = 1536; J.mode = 2; }
        else if (j == 11) { J.W = in[14]; J.gain = in[6] + D; J.Wt = WB + WO_Q; J.K = D; J.N = D; J.mode = 2; }
        else if (j == 12) { J.W = in[17]; J.gain = nullptr; J.Wt = WB + WO_BOUT; J.K = D; J.N = D; J.mode = 0; }
        else { const int l = j - 13; J.W = in[8] + (size_t)l * D * 512; J.gain = in[7] + l * D; J.Wt = WB + WO_MKV + (size_t)l * 512 * D; J.K = D; J.N = 512; J.mode = 0; }
        transpose_item(J, scr, r, lane);
    }
}
__device__ __forceinline__ void tail_convert(ArgsP ap, LAS unsigned char* lds, int M, int N, int G, int bx, int tid, int chunk, int tskip) {
    int rem = ((M / 256) * (N / 256)) % G;
    if (chunk <= 0 || rem == 0) return;
    rem += tskip; if (bx < rem || rem >= G) return;
    const int lane = tid & 63, wave = tid >> 6;
    convert_chunk(ap, (LAS float*)(lds + wave * 16384), (bx - rem) * NWAVES + wave, (G - rem) * NWAVES, lane, chunk);
    __syncthreads();
}
__device__ __forceinline__ void prep_phase(ArgsP ap, LAS unsigned char* lds, int vcu, int G, int tid) {
    const int lane = tid & 63, wave = tid >> 6;
    LAS float* scr = (LAS float*)(lds + wave * 16384);
    const int gw = vcu * NWAVES + wave, NGW = G * NWAVES;
    unsigned char* ws = ap->ws;
    typedef const float* cfp_t; const __attribute__((address_space(4))) cfp_t* in = (const __attribute__((address_space(4))) cfp_t*)ap->in;
    convert_chunk(ap, scr, gw, NGW, lane, 0);
    { const float* x = in[0]; bf16* hb = (bf16*)(ws + WS_HB); float* ssq = (float*)(ws + WS_SSQ); const int* pos = (const int*)ap->in[2]; float* cs = (float*)(ws + WS_CS);
      const int i = lane & 7;
      const float invf = i == 0 ? 1.0f : i == 1 ? 0x1.8d275ep-3f : i == 2 ? 0x1.341190p-5f : i == 3 ? 0x1.ddee9cp-8f : i == 4 ? 0x1.72ba44p-10f : i == 5 ? 0x1.1f91f0p-12f : i == 6 ? 0x1.be2188p-15f : 0x1.5a0f4ep-17f;
      for (int m = gw; m < T; m += NGW) { const float ang = (float)pos[m] * invf;
          row_to_bf16(x + (size_t)m * D, hb + (size_t)m * D, ssq + (size_t)m * 4, lane);
          double rev = (double)ang * 0.15915494309189533577; rev -= __builtin_floor(rev); const float f = (float)rev;
          if (lane < 8) { __hip_atomic_store(cs + (size_t)m * 16 + i, __builtin_amdgcn_cosf(f), __ATOMIC_RELAXED, __HIP_MEMORY_SCOPE_AGENT); __hip_atomic_store(cs + (size_t)m * 16 + 8 + i, __builtin_amdgcn_sinf(f), __ATOMIC_RELAXED, __HIP_MEMORY_SCOPE_AGENT); } }
      const float* mem = in[1]; bf16* mb = (bf16*)(ws + WS_MEMB); float* sm = (float*)(ws + WS_SSQM);
      for (int m = gw; m < BATCH * NMEM; m += NGW) row_to_bf16(mem + (size_t)m * D, mb + (size_t)m * D, sm + (size_t)m * 4, lane); }
}

constexpr int MA_KS = 72, MA_VS = 264;
__device__ __forceinline__ void mem_attn_unit(LAS unsigned char* lds, const bf16* Q, int pq, const bf16* KV, bf16* Y, int py, int b, int h, int tb, int tid) {
    LAS bf16* Ks = (LAS bf16*)lds; LAS bf16* Vt = (LAS bf16*)(lds + 256 * MA_KS * 2);
    const int lane = tid & 63, wid = tid >> 6, r32 = lane & 31, hi = lane >> 5;
    const size_t t0 = (size_t)b * SEQ + tb * 256 + wid * 32;
    const bf16* qp = Q + (t0 + r32) * pq + h * 64 + hi * 8;
    bf16x8 qr[4];
#pragma unroll
    for (int d0 = 0; d0 < 4; ++d0) qr[d0] = *(const bf16x8*)(qp + d0 * 16);
    __syncthreads();
#pragma unroll
    for (int i = 0; i < 4; ++i) { const int idx = tid + NTHR * i, row = idx >> 3, chn = idx & 7;
        const bf16* src = KV + (size_t)(b * NMEM + row) * 512 + h * 64 + chn * 8;
        const v4u kk = *(const v4u*)src; *(LAS v4u*)(Ks + row * MA_KS + chn * 8) = kk;
        const v4u vv = *(const v4u*)(src + 256);
#pragma unroll
        for (int j = 0; j < 4; ++j) { Vt[(chn * 8 + 2 * j) * MA_VS + row] = (bf16)(vv[j] & 0xffffu); Vt[(chn * 8 + 2 * j + 1) * MA_VS + row] = (bf16)(vv[j] >> 16); } }
    __syncthreads();
    f32x16 s[8];
#pragma unroll
    for (int kb = 0; kb < 8; ++kb) { s[kb] = f32x16{};
#pragma unroll
        for (int d0 = 0; d0 < 4; ++d0) { const bf16x8 a = *(const LAS bf16x8*)(Ks + (kb * 32 + r32) * MA_KS + d0 * 16 + hi * 8); s[kb] = __builtin_amdgcn_mfma_f32_32x32x16_bf16(a, qr[d0], s[kb], 0, 0, 0); } }
    float mx = s[0][0];
#pragma unroll
    for (int kb = 0; kb < 8; ++kb)
#pragma unroll
        for (int r = 0; r < 16; ++r) mx = fmaxf(mx, s[kb][r]);
    mx = fmaxf(mx, __shfl_xor(mx, 32));
    const float mc = mx * C2; float l = 0.f;
    f32x16 o[2]; o[0] = f32x16{}; o[1] = f32x16{};
#pragma unroll
    for (int kb = 0; kb < 8; ++kb) {
#pragma unroll
        for (int r = 0; r < 16; ++r) { const float p = __builtin_amdgcn_exp2f(s[kb][r] * C2 - mc); s[kb][r] = p; l += p; }
#pragma unroll
        for (int s2 = 0; s2 < 2; ++s2) { v4u pw; pw.x = pk2(s[kb][8 * s2 + 0], s[kb][8 * s2 + 1]); pw.y = pk2(s[kb][8 * s2 + 2], s[kb][8 * s2 + 3]); pw.z = pk2(s[kb][8 * s2 + 4], s[kb][8 * s2 + 5]); pw.w = pk2(s[kb][8 * s2 + 6], s[kb][8 * s2 + 7]);
            const bf16x8 pb = __builtin_bit_cast(bf16x8, pw);
#pragma unroll
            for (int db = 0; db < 2; ++db) { const LAS bf16* vp = Vt + (db * 32 + r32) * MA_VS + kb * 32 + 16 * s2 + 4 * hi;
                const s16x4 lo = *(const LAS s16x4*)vp, hh = *(const LAS s16x4*)(vp + 8);
                const bf16x8 a = (bf16x8){lo[0], lo[1], lo[2], lo[3], hh[0], hh[1], hh[2], hh[3]};
                o[db] = __builtin_amdgcn_mfma_f32_32x32x16_bf16(a, pb, o[db], 0, 0, 0); } }
        __builtin_amdgcn_sched_barrier(0);
    }
    l += __shfl_xor(l, 32);
    const float inv = 1.0f / l;
    bf16* yp = Y + (t0 + r32) * py + h * 64 + 4 * hi;
#pragma unroll
    for (int db = 0; db < 2; ++db)
#pragma unroll
        for (int g = 0; g < 4; ++g) { v2u w; w.x = pk2(o[db][4 * g] * inv, o[db][4 * g + 1] * inv); w.y = pk2(o[db][4 * g + 2] * inv, o[db][4 * g + 3] * inv); __hip_atomic_store((unsigned long long*)(yp + db * 32 + 8 * g), ((unsigned long long)w.y << 32) | w.x, __ATOMIC_RELAXED, __HIP_MEMORY_SCOPE_AGENT); }
}
__device__ __forceinline__ void mem_attn_phase(LAS unsigned char* lds, const bf16* Q, int pq, const bf16* KV, bf16* Y, int py, int vcu, int G, int tid) {
    for (int u = vcu; u < BATCH * 4 * (SEQ / 256); u += G) { const int tb = u & 31, h = (u >> 5) & 3, b = u >> 7; mem_attn_unit(lds, Q, pq, KV, Y, py, b, h, tb, tid); }
    __syncthreads();
}

__device__ __forceinline__ void unpack8(const v4u w, float* f) { f[0] = bf_lo(w.x); f[1] = bf_hi(w.x); f[2] = bf_lo(w.y); f[3] = bf_hi(w.y); f[4] = bf_lo(w.z); f[5] = bf_hi(w.z); f[6] = bf_lo(w.w); f[7] = bf_hi(w.w); }
__device__ __forceinline__ void conv_phase(const bf16* proj, bf16* y, const float* cw, int vcu, int G, int tid) {
    constexpr int RUN = 16, NCG = MIX / 8;
    for (int it = vcu * NTHR + tid; it < (T / RUN) * NCG; it += G * NTHR) {
        const int r = it / NCG, cg = it % NCG, t0 = r * RUN, ch = cg * 8;
        float w0[8], w1[8], w2[8], c1[8], c2[8];
#pragma unroll
        for (int i = 0; i < 8; ++i) { w0[i] = cw[ch + i]; w1[i] = cw[MIX + ch + i]; w2[i] = cw[2 * MIX + ch + i]; c1[i] = 0.f; c2[i] = 0.f; }
        if ((t0 & (SEQ - 1)) != 0) {
            const bf16* p2 = proj + (size_t)(t0 - 2) * PROJS + MIX + ch;
            unpack8(*(const v4u*)p2, c2); unpack8(*(const v4u*)(p2 + PROJS), c1); }
#pragma unroll 8
        for (int tt = 0; tt < RUN; ++tt) { const bf16* p = proj + (size_t)(t0 + tt) * PROJS + ch; float bg[8], cx[8], o[8];
            unpack8(__builtin_nontemporal_load((const v4u*)p), bg); unpack8(__builtin_nontemporal_load((const v4u*)(p + MIX)), cx);
#pragma unroll
            for (int i = 0; i < 8; ++i) { o[i] = bg[i] * (w0[i] * c2[i] + w1[i] * c1[i] + w2[i] * cx[i]); c2[i] = c1[i]; c1[i] = cx[i]; }
            v4u w; w.x = pk2(o[0], o[1]); w.y = pk2(o[2], o[3]); w.z = pk2(o[4], o[5]); w.w = pk2(o[6], o[7]);
            st16_wt(y + (size_t)(t0 + tt) * D + ch, w); }
    }
}

__device__ __forceinline__ void combine_phase(const bf16* Ob, bf16* y, const float* lamp, const float* subln, int vcu, int G, int tid) {
    const int lane = tid & 63;
    const float d01 = wave_sum(lamp[lane] * lamp[64 + lane]), d23 = wave_sum(lamp[128 + lane] * lamp[192 + lane]);
    const float lam = expf(d01) - expf(d23) + LAM_INIT;
    const int sub = tid & 15, e = sub * 8;
    float gsub[8];
#pragma unroll
    for (int i = 0; i < 8; ++i) gsub[i] = subln[e + i] * (1.0f - LAM_INIT);
    for (int it = (vcu * NTHR + tid) >> 4; it < T * 6; it += (G * NTHR) >> 4) { const int t = it / 6, h = it % 6;
        const size_t off = (size_t)t * MIX + h * 128 + e; float a[8], bq[8], o[8]; float ss = 0.f;
        unpack8(__builtin_nontemporal_load((const v4u*)(Ob + off)), a); unpack8(__builtin_nontemporal_load((const v4u*)(Ob + (size_t)T * MIX + off)), bq);
#pragma unroll
        for (int i = 0; i < 8; ++i) { o[i] = a[i] - lam * bq[i]; ss += o[i] * o[i]; }
        ss += __shfl_xor(ss, 1); ss += __shfl_xor(ss, 2); ss += __shfl_xor(ss, 4); ss += __shfl_xor(ss, 8);
        const float rs = 1.0f / sqrtf(ss * (1.0f / 128.0f) + EPS);
        v4u w; w.x = pk2(o[0] * rs * gsub[0], o[1] * rs * gsub[1]); w.y = pk2(o[2] * rs * gsub[2], o[3] * rs * gsub[3]); w.z = pk2(o[4] * rs * gsub[4], o[5] * rs * gsub[5]); w.w = pk2(o[6] * rs * gsub[6], o[7] * rs * gsub[7]);
        st16_wt(y + (size_t)t * D + h * 128 + e, w); }
}
__device__ __forceinline__ void final_phase(float* out, const float* g, const bf16* hb, int vcu, int G, int tid) {
    const int lane = tid & 63, gw = vcu * NWAVES + (tid >> 6), NGW = G * NWAVES;
    f32x4 gv[4];
#pragma unroll
    for (int j = 0; j < 4; ++j) gv[j] = ((const f32x4*)g)[2 * lane + (j & 1) + 128 * (j >> 1)];
    for (int m = gw; m < T; m += NGW) { const v4u* hr = (const v4u*)(hb + (size_t)m * D) + lane; f32x4 v[4]; float s = 0.f;
#pragma unroll
        for (int j = 0; j < 2; ++j) { const v4u w = hr[64 * j]; v[2 * j] = (f32x4){bf_lo(w.x), bf_hi(w.x), bf_lo(w.y), bf_hi(w.y)}; v[2 * j + 1] = (f32x4){bf_lo(w.z), bf_hi(w.z), bf_lo(w.w), bf_hi(w.w)}; }
#pragma unroll
        for (int j = 0; j < 4; ++j) s += (v[j][0] * v[j][0] + v[j][1] * v[j][1]) + (v[j][2] * v[j][2] + v[j][3] * v[j][3]);
        const float rs = __builtin_amdgcn_rsqf(wave_sum(s) * (1.0f / D) + EPS);
        f32x4* orow = (f32x4*)(out + (size_t)m * D);
#pragma unroll
        for (int j = 0; j < 4; ++j) orow[2 * lane + (j & 1) + 128 * (j >> 1)] = v[j] * rs * gv[j]; }
}

#define RLX_AGENT __ATOMIC_RELAXED, __HIP_MEMORY_SCOPE_AGENT
#define XB_TMO      128
#define XB_XCNT(j)  (256  + 64 * (j))
#define XB_XSUB(j)  (1280 + 64 * (j))
#define XB_XGEN(j)  (2304 + 64 * (j))
#define XB_TOP      3328
#define XB_TOPGEN   3392
#define XCD_BAR_WORDS 3456
#define XB_SPIN_CAP (1u << 18)

__device__ __forceinline__ unsigned xb_ld(unsigned* p)              { return __hip_atomic_load(p, __ATOMIC_RELAXED, __HIP_MEMORY_SCOPE_AGENT); }
__device__ __forceinline__ unsigned xb_add(unsigned* p, unsigned v) { return __hip_atomic_fetch_add(p, v, __ATOMIC_RELAXED, __HIP_MEMORY_SCOPE_AGENT); }
__device__ __forceinline__ unsigned xb_xcc_id() { return (unsigned)__builtin_amdgcn_s_getreg((3 << 11) | 20) & 0xFu; }
#define XB_SPIN(cond, bar) do { unsigned _sp = 0; while (cond) { __builtin_amdgcn_s_sleep(1); \
    if ((++_sp & 255u) == 0u) { if (xb_ld(&(bar)[XB_TMO])) break; if (_sp > XB_SPIN_CAP) { atomicAdd(&(bar)[XB_TMO], 1u); break; } } } } while (0)

struct XcdBarrier {
    unsigned* bar; unsigned x;
    volatile LAS unsigned* st;
};

__device__ __forceinline__ XcdBarrier xcd_barrier_post(unsigned* bar, volatile LAS unsigned* st) {
    XcdBarrier b; b.bar = bar; b.x = xb_xcc_id(); b.st = st;
    if (threadIdx.x == 0) (void)xb_add(&bar[XB_XCNT(b.x)], 1u);
    return b;
}
__device__ __forceinline__ void xcd_barrier_complete(unsigned* bar, unsigned x, unsigned& nloc, unsigned& nx) {
    const unsigned G = gridDim.x * gridDim.y * gridDim.z;
    unsigned sum, cnt, mine, sp = 0u;
    for (;;) {
        sum = 0u; cnt = 0u; mine = 0u;
#pragma unroll
        for (unsigned j = 0; j < 16; ++j) { const unsigned c = xb_ld(&bar[XB_XCNT(j)]); sum += c; cnt += (c > 0u) ? 1u : 0u; mine = (j == x) ? c : mine; }
        if (sum == G) break;
        __builtin_amdgcn_s_sleep(1);
        if ((++sp & 255u) == 0u) { if (xb_ld(&bar[XB_TMO])) break; if (sp > XB_SPIN_CAP) { atomicAdd(&bar[XB_TMO], 1u); break; } }
    }
    nloc = mine > 0u ? mine : 1u; nx = cnt > 0u ? cnt : 1u;
}

#define GB_SUB(g) (4096 + 64 * (g))
#define GB_GEN(g) (4608 + 64 * (g))
__device__ __forceinline__ void group_barrier(const XcdBarrier& b, unsigned g, unsigned nmem) {
    asm volatile("s_waitcnt vmcnt(0)" ::: "memory");
    __syncthreads();
    if (threadIdx.x == 0) {
        unsigned* bar = b.bar;
        __builtin_amdgcn_s_waitcnt(0);
        const unsigned old = xb_add(&bar[GB_SUB(g)], 1u);
        const unsigned gen = old / nmem;
        asm volatile("buffer_inv sc1" ::: "memory");
        if (old + 1u == (gen + 1u) * nmem) xb_add(&bar[GB_GEN(g)], 1u);
        else XB_SPIN(xb_ld(&bar[GB_GEN(g)]) == gen, bar);
        asm volatile("s_waitcnt vmcnt(0)" ::: "memory");
    }
    __syncthreads();
}

__device__ __forceinline__ void xcd_barrier(const XcdBarrier& b) {
    asm volatile("s_waitcnt vmcnt(0)" ::: "memory");
    __syncthreads();
    if (threadIdx.x == 0) {
        unsigned* bar = b.bar;
        __builtin_amdgcn_s_waitcnt(0);
        unsigned nloc = b.st[0], nx = b.st[1];
        if (nloc == 0u) { xcd_barrier_complete(bar, b.x, nloc, nx); b.st[0] = nloc; b.st[1] = nx; }
        const unsigned old = xb_add(&bar[XB_XSUB(b.x)], 1u);
        const unsigned gen = old / nloc;
        if (old + 1u == (gen + 1u) * nloc) {
            asm volatile("buffer_wbl2 sc1\n\tbuffer_inv sc1\n\ts_waitcnt vmcnt(0)" ::: "memory");
            const unsigned og = xb_add(&bar[XB_TOP], 1u);
            const unsigned tg = og / nx;
            if (og + 1u == (tg + 1u) * nx) xb_add(&bar[XB_TOPGEN], 1u);
            else XB_SPIN(xb_ld(&bar[XB_TOPGEN]) == tg, bar);
            xb_add(&bar[XB_XGEN(b.x)], 1u);
            asm volatile("s_waitcnt vmcnt(0)" ::: "memory");
        } else {
            asm volatile("buffer_inv sc1" ::: "memory");
            XB_SPIN(xb_ld(&bar[XB_XGEN(b.x)]) == gen, bar);
            asm volatile("s_waitcnt vmcnt(0)" ::: "memory");
        }
    }
    __syncthreads();
}

__global__ void __launch_bounds__(NTHR, 2) mk_fwd(Args args) {
    extern __shared__ __attribute__((aligned(16))) unsigned char lds_raw[];
    LAS unsigned char* lds = (LAS unsigned char*)lds_raw;
    const int G = gridDim.x, bx = blockIdx.x;
    const int vcu = (G % 8 == 0) ? (bx % 8) * (G / 8) + bx / 8 : bx;
    volatile LAS unsigned* bst = (volatile LAS unsigned*)(lds + LDS_BYTES - 64);
    if (threadIdx.x < 2) bst[threadIdx.x] = 0u;
    __syncthreads();
    const XcdBarrier bar = xcd_barrier_post((unsigned*)args.ws, bst);
    const int s_lo = args.lo, s_hi = args.hi;
    for (int si = s_lo; si < s_hi; ++si) {
        ArgsP ap = (ArgsP)__builtin_amdgcn_kernarg_segment_ptr(); asm volatile("" : "+s"(ap));
        const __attribute__((address_space(4))) Step& st = ap->steps[si];
        int tid = threadIdx.x; asm volatile("" : "+v"(tid));
        const int kind = st.kind;
#ifndef MK_KMASK
#define MK_KMASK 0x1ff
#endif
#define KON(k) ((MK_KMASK >> (k)) & 1)
        if (KON(K_PREP) && kind == K_PREP) prep_phase(ap, lds, vcu, G, tid);
        else if (KON(K_SWIGLU) && kind == K_SWIGLU) { pg8::Gemm g{(const pg8::bf16_t*)st.A, (const pg8::bf16_t*)st.Bt, st.M, st.N, st.K}; pg8::StaticOrder S; S.init(st.M, st.N, G, bx);
            pg8::EpiSwiGLU E{(pg8::bf16_t*)st.p0, st.ldc, (const float*)st.p1, st.pad, (pg8::bf16_t*)st.p2, 1536, (const float*)st.p3}; pg8::gemm_phase<pg8::EpiSwiGLU, pg8::StaticOrder, true, true>(lds, g, S, E); tail_convert(ap, lds, st.M, st.N, G, bx, tid, (int)st.scale, st.tskip); }
        else if (KON(K_RES) && kind == K_RES) { pg8::Gemm g{(const pg8::bf16_t*)st.A, (const pg8::bf16_t*)st.Bt, st.M, st.N, st.K}; pg8::StaticOrder S; S.init(st.M, st.N, G, bx);
            pg8::EpiRes E{(pg8::bf16_t*)st.p2, (float*)st.p3, st.scale, (PG8_LAS float*)(lds + 131072)}; pg8::gemm_phase<pg8::EpiRes, pg8::StaticOrder, true, true>(lds, g, S, E); }
        else if (KON(K_SCALE) && kind == K_SCALE) { pg8::Gemm g{(const pg8::bf16_t*)st.A, (const pg8::bf16_t*)st.Bt, st.M, st.N, st.K}; pg8::StaticOrder S; S.init(st.M, st.N, G, (bx - st.coff + G) % G);
            pg8::EpiScale E{(pg8::bf16_t*)st.p0, st.ldc, (const float*)st.p1, st.pad & 255, (st.pad & 255) + (st.pad >> 8)}; pg8::gemm_phase<pg8::EpiScale, pg8::StaticOrder, true, true>(lds, g, S, E); tail_convert(ap, lds, st.M, st.N, G, bx, tid, (int)st.scale, st.tskip); }
        else if (KON(K_ROPE) && kind == K_ROPE) { pg8::Gemm g{(const pg8::bf16_t*)st.A, (const pg8::bf16_t*)st.Bt, st.M, st.N, st.K}; pg8::StaticOrder S; S.init(st.M, st.N, G, bx);
            pg8::EpiRope E{(pg8::bf16_t*)st.p0, st.ldc, (const float*)st.p1, (const float*)st.p2, st.scale}; pg8::gemm_phase<pg8::EpiRope, pg8::StaticOrder, true, true>(lds, g, S, E); }
        else if (KON(K_MIXA) && kind == K_MIXA) { conv_phase((const bf16*)st.A, (bf16*)st.p0, (const float*)st.p1, vcu, G, tid);
            mem_attn_phase(lds, (const bf16*)st.A + 2 * MIX, PROJS, (const bf16*)st.p2, (bf16*)st.p0 + MIX, D, vcu, G, tid); }
        else if (KON(K_ATTN) && kind == K_ATTN) { attn_body::attn_phase<8>((char*)lds_raw, (const attn_body::bf16*)st.A, (const attn_body::bf16*)st.Bt, (const attn_body::bf16*)st.Bt + MIX, (attn_body::bf16*)st.p0, vcu, G); }
        else if (KON(K_COMB) && kind == K_COMB) { combine_phase((const bf16*)st.A, (bf16*)st.p0, (const float*)st.p1, (const float*)st.p2, vcu, G, tid);
            mem_attn_phase(lds, (const bf16*)st.p0 + MIX, D, (const bf16*)st.p3, (bf16*)st.p0 + MIX, D, vcu, G, tid); }
        else if (KON(K_FINAL) && kind == K_FINAL) final_phase((float*)st.p0, (const float*)st.p1, (const bf16*)st.p2, vcu, G, tid);
        if (st.sync_after && si + 1 < s_hi) { if (st.sync_after == 2) group_barrier(bar, (unsigned)bx & 7u, (unsigned)G >> 3); else xcd_barrier(bar); }
    }
}

#ifndef MK_ONE_LAUNCH
#define MK_ONE_LAUNCH 1
#endif
extern "C" void kernel_launch(void* const* d_in, const int* in_sizes, int n_in, void* d_out, int out_size, void* d_ws, size_t ws_size, hipStream_t stream) {
    static int grid = 0;
    if (grid == 0) {
        if (n_in != 22 || in_sizes[0] != T * D || out_size != T * D || ws_size < WS_END) { fprintf(stderr, "kernel_launch: unexpected problem (n_in %d, in0 %d, out %d, ws %zu)\n", n_in, n_in > 0 ? in_sizes[0] : -1, out_size, ws_size); grid = -1; return; }
        int dev = 0, cus = 0, per_cu = 0;
        if (hipGetDevice(&dev) != hipSuccess || hipDeviceGetAttribute(&cus, hipDeviceAttributeMultiprocessorCount, dev) != hipSuccess) { grid = -1; return; }
        if (hipFuncSetAttribute((const void*)mk_fwd, hipFuncAttributeMaxDynamicSharedMemorySize, LDS_BYTES) != hipSuccess) { fprintf(stderr, "kernel_launch: hipFuncSetAttribute failed\n"); grid = -1; return; }
        if (hipOccupancyMaxActiveBlocksPerMultiprocessor(&per_cu, (const void*)mk_fwd, NTHR, LDS_BYTES) != hipSuccess || per_cu < 1) { fprintf(stderr, "kernel_launch: occupancy query says %d\n", per_cu); per_cu = 1; }
        (void)hipGetLastError();
        grid = cus;
    }
    if (grid < 0) return;
    unsigned char* ws = (unsigned char*)d_ws; bf16* WB = (bf16*)(ws + WS_W);
    bf16* hb = (bf16*)(ws + WS_HB); bf16* act = (bf16*)(ws + WS_ACT); bf16* kvb = (bf16*)(ws + WS_KV); bf16* y0 = (bf16*)(ws + WS_KV); bf16* qb = (bf16*)(ws + WS_ACT); bf16* ob = (bf16*)(ws + WS_OB);
    float* ssq = (float*)(ws + WS_SSQ); float* cs = (float*)(ws + WS_CS); bf16* memb = (bf16*)(ws + WS_MEMB); bf16* memkv = (bf16*)(ws + WS_MEMKV); float* ssqm = (float*)(ws + WS_SSQM);
    float* out = (float*)d_out;
    Args a{}; int n = 0;
    auto add = [&](int kind, int sync, int M, int N, int K, int ldc, float scale, const void* A, const void* Bt, void* p0, void* p1, void* p2, void* p3) {
        Step& s = a.steps[n++]; s.kind = kind; s.sync_after = sync; s.M = M; s.N = N; s.K = K; s.ldc = ldc; s.scale = scale; s.pad = 0; s.coff = 0; s.tskip = 0; s.A = A; s.Bt = Bt; s.p0 = p0; s.p1 = p1; s.p2 = p2; s.p3 = p3; };
    add(K_PREP, 1, 0, 0, 0, 0, 0.f, nullptr, nullptr, nullptr, nullptr, nullptr, nullptr);
    add(K_SCALE, 0, 512, 512, D, 512, 0.f, memb, WB + WO_MKV, memkv, ssqm, nullptr, nullptr); a.steps[n - 1].coff = 128;
    add(K_SCALE, 0, 512, 512, D, 512, 0.f, memb, WB + WO_MKV + (size_t)512 * D, memkv + 512 * 512, ssqm, nullptr, nullptr); a.steps[n - 1].coff = 132;
    add(K_SWIGLU, 1, T, 2 * FF, D, FF, 1.f, hb, WB + WO_W1_0, act, ssq, nullptr, nullptr); a.steps[n - 1].tskip = 8;
    add(K_RES, 1, T, D, FF, D, 0.5f, act, WB + WO_W2, nullptr, nullptr, hb, ssq);
    add(K_SCALE, 1, T, PROJW, D, PROJS, 2.f, hb, WB + WO_AIN, act, ssq, nullptr, nullptr); a.steps[n - 1].pad = 3 | (6 << 8);
    add(K_MIXA, 1, 0, 0, 0, 0, 0.f, act, nullptr, y0, (void*)d_in[10], memkv, nullptr);
    add(K_RES, 1, T, D, D, D, 1.0f, y0, WB + WO_AOUT, nullptr, nullptr, hb, ssq);
    add(K_SWIGLU, 1, T, 2 * FF, D, FF, 3.f, hb, WB + WO_W1_1, act, ssq, nullptr, nullptr);
    add(K_RES, 1, T, D, FF, D, 0.5f, act, WB + WO_W2 + W2_SZ, nullptr, nullptr, hb, ssq);
    add(K_SWIGLU, 1, T, 1536 + 2 * FF, D, FF, 0.f, hb, WB + WO_KV, act, ssq, kvb, cs); a.steps[n - 1].pad = 6;
    add(K_RES, 1, T, D, FF, D, 0.5f, act, WB + WO_W2 + 2 * W2_SZ, nullptr, nullptr, hb, ssq);
    add(K_ROPE, 1, T, D, D, D, C2, hb, WB + WO_Q, qb, ssq, cs, nullptr);
    add(K_ATTN, 1, 0, 0, 0, 0, 0.f, qb, kvb, ob, nullptr, nullptr, nullptr);
    add(K_COMB, 1, 0, 0, 0, 0, 0.f, ob, nullptr, qb, (void*)d_in[15], (void*)d_in[16], memkv + 512 * 512);
    add(K_RES, 1, T, D, D, D, 1.0f, qb, WB + WO_BOUT, nullptr, nullptr, hb, ssq);
    add(K_SWIGLU, 1, T, 2 * FF, D, FF, 0.f, hb, WB + WO_W1_3, act, ssq, nullptr, nullptr);
    add(K_RES, 1, T, D, FF, D, 0.5f, act, WB + WO_W2 + 3 * W2_SZ, nullptr, nullptr, hb, ssq);
    add(K_FINAL, 0, 0, 0, 0, 0, 0.f, nullptr, nullptr, out, (void*)d_in[21], hb, nullptr);
#ifndef MK_REPMASK
#define MK_REPMASK 0
#endif
#ifndef MK_EXTRASYNC
#define MK_EXTRASYNC 0
#endif
    if (MK_REPMASK || MK_EXTRASYNC) {
        Step tmp[MAX_STEPS]; int m = 0;
        for (int i = 0; i < n; ++i) { tmp[m++] = a.steps[i];
            if ((MK_REPMASK >> i) & 1) { if (!a.steps[i].sync_after) { tmp[m - 1].sync_after = 1; } Step d = a.steps[i]; d.sync_after = 1; if (d.kind == K_RES) { d.scale = 0.f; } tmp[m++] = d; }
            if (i == 5) for (int q = 0; q < MK_EXTRASYNC; ++q) { Step d{}; d.kind = 99; d.sync_after = 1; tmp[m++] = d; } }
        n = m; for (int i = 0; i < n; ++i) a.steps[i] = tmp[i];
    }
#if MK_ONE_LAUNCH
    if (!(MK_REPMASK || MK_EXTRASYNC) && grid % 8 == 0) { const int seams[5] = {3, 7, 8, 10, 16}; for (int q = 0; q < 5; ++q) a.steps[seams[q]].sync_after = 2; }
#endif
    for (int i = 0; i < 22; ++i) a.in[i] = d_in[i];
    a.out = out; a.ws = ws;
    if (hipMemsetAsync(ws + WS_CTL, 0, 24576, stream) != hipSuccess) { fprintf(stderr, "kernel_launch: memset failed\n"); return; }
#if MK_ONE_LAUNCH
    a.lo = 0; a.hi = n;
    void* kargs[] = {&a};
    hipError_t e = hipLaunchCooperativeKernel((const void*)mk_fwd, dim3(grid), dim3(NTHR), kargs, LDS_BYTES, stream);
    if (e != hipSuccess) fprintf(stderr, "kernel_launch: cooperative launch failed: %s\n", hipGetErrorString(e));
#else
    for (int lo = 0; lo < n;) { int hi = lo; while (hi < n && !a.steps[hi].sync_after) ++hi; if (hi < n) ++hi;
        a.lo = lo; a.hi = hi; hipLaunchKernelGGL(mk_fwd, dim3(grid), dim3(NTHR), LDS_BYTES, stream, a); lo = hi; }
#endif
}
```
